# Optimizing an MI355X kernel written in HIP

```python
import functools
import jax
import jax.numpy as jnp
from jax import lax
import numpy as np

D_MODEL = 1024
BATCH = 2
SEQ = 8192
DEPTH = 2
DEC_BATCH = 32
DEC_SEQ = 4
PAST_LEN = 16384
PAGE_SIZE = 128

HEAD_DIM = 64
HEADS_PER_GROUP = 8
GROUPS = ((128, 1), (512, 4), (2048, 16))
N_GROUPS = 3
SPAN = 128
N_KEYS = SPAN + 1
ATTN_DIM = N_GROUPS * HEADS_PER_GROUP * HEAD_DIM
ATTN_OUT_DIM = HEADS_PER_GROUP * HEAD_DIM
CONV_DIM = D_MODEL
CONV_WIDTH = 3
D_FF = 2816
QBLOCK = 128
IN_DIM = 3 * ATTN_DIM + 3 * CONV_DIM + 2 * D_MODEL
RMS_EPS = 1e-6
FFN_RESIDUAL_WEIGHT = 0.5
ATTN_SCALE = HEAD_DIM ** -0.5
NEG = -1e30

kernel_name = "dilated_swa_shortconv_gated_hybrid_step"


def rmsnorm(x, g):
    xf = x.astype(jnp.float32)
    inv = lax.rsqrt(jnp.mean(xf * xf, axis=-1, keepdims=True) + RMS_EPS)
    return (xf * inv).astype(x.dtype) * g


def half_swiglu(x, g, w_in, w_out):
    h = rmsnorm(x, g) @ w_in
    gate, up = jnp.split(h, 2, axis=-1)
    return FFN_RESIDUAL_WEIGHT * ((jax.nn.silu(gate) * up) @ w_out)


def split_proj(u, w_in, b_gate):
    z = u @ w_in
    cuts = [ATTN_DIM, 2 * ATTN_DIM, 3 * ATTN_DIM, 3 * ATTN_DIM + CONV_DIM,
            3 * ATTN_DIM + 2 * CONV_DIM, 3 * ATTN_DIM + 3 * CONV_DIM]
    q, k, v, c_b, c_c, c_h, gates = jnp.split(z, cuts, axis=-1)
    heads = lambda a: a.reshape(a.shape[0], a.shape[1], N_GROUPS, HEADS_PER_GROUP, HEAD_DIM)
    g_attn, g_conv = jnp.split(jax.nn.sigmoid(gates + b_gate), 2, axis=-1)
    return heads(q), heads(k), heads(v), c_b, c_c, c_h, g_attn, g_conv


def dilated_attn_prompt(q, k, v, dil):
    b, s, h, e = q.shape
    L = s // dil
    nb = -(-L // QBLOCK)
    lp = nb * QBLOCK

    def by_stride(a):
        a = a.reshape(b, L, dil, h, e).transpose(0, 2, 1, 3, 4)
        a = jnp.pad(a, ((0, 0), (0, 0), (0, lp - L), (0, 0), (0, 0)))
        return a.reshape(b, dil, nb, QBLOCK, h, e)

    def with_prev(a):
        prev = jnp.pad(a[:, :, :-1], ((0, 0), (0, 0), (1, 0), (0, 0), (0, 0), (0, 0)))
        return jnp.concatenate([prev, a], axis=3)

    qs = by_stride(q)
    kb = with_prev(by_stride(k))
    vb = with_prev(by_stride(v))
    scores = jnp.einsum('brnqhe,brnkhe->brnhqk', qs, kb,
                        preferred_element_type=jnp.float32) * ATTN_SCALE
    qi = jnp.arange(QBLOCK)[:, None]
    ki = jnp.arange(2 * QBLOCK)[None, :]
    rel = QBLOCK + qi - ki
    key_u = jnp.arange(nb)[:, None, None] * QBLOCK - QBLOCK + ki[None]
    valid = (rel >= 0) & (rel <= SPAN) & (key_u >= 0)
    scores = jnp.where(valid[:, None], scores, NEG)
    lse = jax.nn.logsumexp(scores, axis=-1)
    p = jnp.exp(scores - lse[..., None])
    o = jnp.einsum('brnhqk,brnkhe->brnqhe', p, vb.astype(jnp.float32))
    o = o.reshape(b, dil, lp, h, e)[:, :, :L].transpose(0, 2, 1, 3, 4).reshape(b, s, h, e)
    lse = lse.transpose(0, 1, 2, 4, 3).reshape(b, dil, lp, h)[:, :, :L]
    lse = lse.transpose(0, 2, 1, 3).reshape(b, s, h)
    return o, lse


def dilated_attn_sample(q, k_new, v_new, kv_buf, dil, window):
    t = q.shape[1]
    lb = kv_buf.shape[1]
    kc = jnp.concatenate([kv_buf[:, :, 0], k_new], axis=1)
    vc = jnp.concatenate([kv_buf[:, :, 1], v_new], axis=1)
    idx = lb + jnp.arange(t)[:, None] - dil * jnp.arange(N_KEYS)[None, :]
    valid = idx >= 0
    idx = jnp.maximum(idx, 0)
    kg = kc[:, idx]
    vg = vc[:, idx]
    scores = jnp.einsum('bthe,btjhe->bthj', q, kg,
                        preferred_element_type=jnp.float32) * ATTN_SCALE
    scores = jnp.where(valid[:, None, :], scores, NEG)
    lse = jax.nn.logsumexp(scores, axis=-1)
    p = jnp.exp(scores - lse[..., None])
    o = jnp.einsum('bthj,btjhe->bthe', p, vg.astype(jnp.float32))
    keep = min(window, lb + t)
    new_buf = jnp.stack([kc[:, -keep:], vc[:, -keep:]], axis=2)
    return o, lse, new_buf


def merge_groups(outs, lses, dtype):
    o = jnp.stack(outs, axis=2)
    w = jax.nn.softmax(jnp.stack(lses, axis=2), axis=2)
    o = jnp.sum(w[..., None] * o, axis=2)
    return o.reshape(o.shape[0], o.shape[1], ATTN_OUT_DIM).astype(dtype)


def attend_prompt(q, k, v):
    outs, lses, bufs = [], [], []
    s = k.shape[1]
    for g, (win, dil) in enumerate(GROUPS):
        o, l = dilated_attn_prompt(q[:, :, g], k[:, :, g], v[:, :, g], dil)
        outs.append(o)
        lses.append(l)
        keep = min(win, s)
        bufs.append(jnp.stack([k[:, -keep:, g], v[:, -keep:, g]], axis=2))
    return merge_groups(outs, lses, q.dtype), bufs


def attend_sample(q, k, v, caches):
    outs, lses, bufs = [], [], []
    for g, (win, dil) in enumerate(GROUPS):
        o, l, nb_ = dilated_attn_sample(q[:, :, g], k[:, :, g], v[:, :, g], caches[g], dil, win)
        outs.append(o)
        lses.append(l)
        bufs.append(nb_)
    return merge_groups(outs, lses, q.dtype), bufs


def short_conv(zc, w):
    t = zc.shape[1] - (CONV_WIDTH - 1)
    return w[0] * zc[:, 0:t] + w[1] * zc[:, 1:t + 1] + w[2] * zc[:, 2:t + 2]


def block(x, attend, conv_prev, w):
    (n1, f1i, f1o, nm, w_in, b_gate, conv_w, w_ao, w_co, w_o, n2, f2i, f2o) = w
    x = x + half_swiglu(x, n1, f1i, f1o)
    u = rmsnorm(x, nm)
    q, k, v, c_b, c_c, c_h, g_attn, g_conv = split_proj(u, w_in, b_gate)
    a, kv_bufs = attend(q, k, v)
    zc = jnp.concatenate([conv_prev.astype(x.dtype), c_c * c_h], axis=1)
    c = c_b * short_conv(zc, conv_w)
    new_conv = zc[:, -(CONV_WIDTH - 1):]
    m = g_attn * (a @ w_ao) + g_conv * (c @ w_co)
    x = x + m @ w_o
    x = x + half_swiglu(x, n2, f2i, f2o)
    return x, kv_bufs, new_conv


def setup_inputs(seed: int = 0) -> dict:
    key = jax.random.key(seed)
    ks = jax.random.split(key, 22)
    f32 = jnp.float32
    nrm = lambda kk, shape, scale: jax.random.normal(kk, shape, f32) * scale
    lens = [min(win, PAST_LEN) for win, _ in GROUPS]
    kvshape = lambda n: (DEPTH, DEC_BATCH, n, 2, HEADS_PER_GROUP, HEAD_DIM)
    return {
        'x_prompt': nrm(ks[0], (BATCH, SEQ, D_MODEL), 1.0),
        'x_sample': nrm(ks[1], (DEC_BATCH, DEC_SEQ, D_MODEL), 1.0),
        'cache_kv1': nrm(ks[2], kvshape(lens[0]), 1.0),
        'cache_kv2': nrm(ks[3], kvshape(lens[1]), 1.0),
        'cache_kv3': nrm(ks[4], kvshape(lens[2]), 1.0),
        'state_conv': nrm(ks[5], (DEPTH, DEC_BATCH, CONV_WIDTH - 1, CONV_DIM), 1.0),
        'ffn1_norm': 1.0 + nrm(ks[6], (DEPTH, D_MODEL), 0.01),
        'ffn1_w_in': nrm(ks[7], (DEPTH, D_MODEL, 2 * D_FF), D_MODEL ** -0.5),
        'ffn1_w_out': nrm(ks[8], (DEPTH, D_FF, D_MODEL), D_FF ** -0.5),
        'mix_norm': 1.0 + nrm(ks[9], (DEPTH, D_MODEL), 0.01),
        'w_in': nrm(ks[10], (DEPTH, D_MODEL, IN_DIM), D_MODEL ** -0.5),
        'b_gate': nrm(ks[11], (DEPTH, 2 * D_MODEL), 0.1),
        'conv_w': nrm(ks[12], (DEPTH, CONV_WIDTH, CONV_DIM), CONV_WIDTH ** -0.5),
        'w_attn_out': nrm(ks[13], (DEPTH, ATTN_OUT_DIM, D_MODEL), ATTN_OUT_DIM ** -0.5),
        'w_conv_out': nrm(ks[14], (DEPTH, CONV_DIM, D_MODEL), CONV_DIM ** -0.5),
        'w_out': nrm(ks[15], (DEPTH, D_MODEL, D_MODEL), D_MODEL ** -0.5),
        'ffn2_norm': 1.0 + nrm(ks[16], (DEPTH, D_MODEL), 0.01),
        'ffn2_w_in': nrm(ks[17], (DEPTH, D_MODEL, 2 * D_FF), D_MODEL ** -0.5),
        'ffn2_w_out': nrm(ks[18], (DEPTH, D_FF, D_MODEL), D_FF ** -0.5),
        'final_norm': 1.0 + nrm(ks[19], (D_MODEL,), 0.01),
    }


def reference(x_prompt, x_sample, cache_kv1, cache_kv2, cache_kv3, state_conv,
              ffn1_norm, ffn1_w_in, ffn1_w_out, mix_norm, w_in, b_gate, conv_w,
              w_attn_out, w_conv_out, w_out, ffn2_norm, ffn2_w_in, ffn2_w_out, final_norm):
    yp, ys = x_prompt, x_sample
    kvp = [[], [], []]
    kvs = [[], [], []]
    convp, convs = [], []
    for l in range(DEPTH):
        w = (ffn1_norm[l], ffn1_w_in[l], ffn1_w_out[l], mix_norm[l], w_in[l], b_gate[l],
             conv_w[l], w_attn_out[l], w_conv_out[l], w_out[l],
             ffn2_norm[l], ffn2_w_in[l], ffn2_w_out[l])
        zeros_ctx = jnp.zeros((yp.shape[0], CONV_WIDTH - 1, CONV_DIM), yp.dtype)
        yp, bufs_p, cv_p = block(yp, attend_prompt, zeros_ctx, w)
        att_s = functools.partial(attend_sample, caches=(cache_kv1[l], cache_kv2[l], cache_kv3[l]))
        ys, bufs_s, cv_s = block(ys, att_s, state_conv[l], w)
        for g in range(N_GROUPS):
            kvp[g].append(bufs_p[g])
            kvs[g].append(bufs_s[g])
        convp.append(cv_p)
        convs.append(cv_s)
    yp = rmsnorm(yp, final_norm)
    ys = rmsnorm(ys, final_norm)
    return (yp, ys,
            jnp.stack(kvp[0]), jnp.stack(kvp[1]), jnp.stack(kvp[2]), jnp.stack(convp),
            jnp.stack(kvs[0]), jnp.stack(kvs[1]), jnp.stack(kvs[2]), jnp.stack(convs))
```

```cpp
#include <hip/hip_runtime.h>
#include <hip/hip_cooperative_groups.h>
#include <cstdio>
#include <cstdint>
namespace cg = cooperative_groups;

#define LAS __attribute__((address_space(3)))
#define EXP_SIG(x) sigmoidf_(x)
#define ABL_A 1.f
#define ABL_C 1.f
typedef unsigned short bf16_t;
typedef short bf16x8 __attribute__((ext_vector_type(8)));
typedef float f32x4 __attribute__((ext_vector_type(4)));
typedef unsigned u32x4 __attribute__((ext_vector_type(4)));
typedef unsigned u32x2 __attribute__((ext_vector_type(2)));

constexpr int DM = 1024, SEQ = 8192, NB = 2, MP = NB * SEQ  , MS = 128, MV = MP + MS  , MPAD = 16640;
constexpr int DFF = 2816, NQKV = 1536, NIN = 9728, NLAYER = 2;
constexpr float RMS_EPS = 1e-6f;
constexpr float QSCALE = 0.125f * 1.4426950408889634f;

constexpr size_t O_YP = 0, O_YS = 16777216, O_KVP0 = 16908288, O_KVP1 = 17432576, O_KVP2 = 19529728, O_CONVP = 27918336,
                 O_KVS0 = 27926528, O_KVS1 = 36315136, O_KVS2 = 69869568, O_CONVS = 204087296;

constexpr size_t al(size_t x) { return (x + 0xFFFFF) & ~(size_t)0xFFFFF; }
constexpr size_t SZ_W1I = (size_t)2 * DFF * DM * 2, SZ_W1O = (size_t)DM * DFF * 2, SZ_WIN = (size_t)NIN * DM * 2, SZ_WAO = (size_t)DM * 512 * 2,
                 SZ_WCO = (size_t)DM * DM * 2, SZ_WO = (size_t)DM * DM * 2;
constexpr size_t LW_W1I = 0, LW_W1O = LW_W1I + SZ_W1I, LW_WIN = LW_W1O + SZ_W1O, LW_WAO = LW_WIN + SZ_WIN, LW_WCO = LW_WAO + SZ_WAO, LW_WO = LW_WCO + SZ_WCO,
                 LW_W2I = LW_WO + SZ_WO, LW_W2O = LW_W2I + SZ_W1I, LW_END = LW_W2O + SZ_W1O;
constexpr size_t WS_W = 0;
constexpr size_t WS_XRES = al(WS_W + 2 * LW_END);
constexpr size_t WS_XB = al(WS_XRES + (size_t)MPAD * DM * 4);
constexpr size_t WS_RSS = al(WS_XB + (size_t)MPAD * DM * 2);
constexpr size_t WS_ACT = al(WS_RSS + (size_t)MPAD * 16 * 4);
constexpr size_t WS_Q = al(WS_ACT + (size_t)MPAD * DFF * 2);
constexpr size_t WS_K = al(WS_Q + (size_t)MPAD * NQKV * 2);
constexpr size_t WS_V = al(WS_K + (size_t)MPAD * NQKV * 2);
constexpr size_t WS_CB = al(WS_V + (size_t)MPAD * NQKV * 2);
constexpr size_t WS_ZC = al(WS_CB + (size_t)MPAD * DM * 2);
constexpr size_t WS_GATES = al(WS_ZC + (size_t)MPAD * DM * 2);
constexpr size_t WS_OG = al(WS_GATES + (size_t)MPAD * 2048 * 2);
constexpr size_t WS_LSE = al(WS_OG + (size_t)3 * MPAD * 512 * 2);
constexpr size_t WS_A = al(WS_LSE + (size_t)MPAD * 24 * 4);
constexpr size_t WS_C = al(WS_A + (size_t)MPAD * 512 * 2);
constexpr size_t WS_MTMP = al(WS_C + (size_t)MPAD * DM * 2);
constexpr size_t WS_M = al(WS_MTMP + (size_t)MPAD * DM * 4);
constexpr size_t WS_CTL = al(WS_M + (size_t)MPAD * DM * 2);
constexpr size_t CTL_BYTES = 65536;
constexpr size_t WS_END = al(WS_CTL + CTL_BYTES);
static_assert(WS_V - WS_K == WS_K - WS_Q, "q/k/v equally spaced");

constexpr int LDS_BYTES = 135168;

typedef float f32x2_t __attribute__((ext_vector_type(2)));
typedef __bf16 bf16x2_t __attribute__((ext_vector_type(2)));
__device__ __forceinline__ unsigned cvt_pk_bf16(float lo, float hi) { const f32x2_t v = {lo, hi}; const bf16x2_t b = __builtin_convertvector(v, bf16x2_t); return __builtin_bit_cast(unsigned, b); }
__device__ __forceinline__ float bf_lo(unsigned w) { return __uint_as_float(w << 16); }
__device__ __forceinline__ float bf_hi(unsigned w) { return __uint_as_float(w & 0xffff0000u); }
__device__ __forceinline__ float bf2f(bf16_t h) { return __uint_as_float((unsigned)h << 16); }
__device__ __forceinline__ u32x4 pack8(f32x4 a, f32x4 b) { u32x4 w; w.x = cvt_pk_bf16(a[0], a[1]); w.y = cvt_pk_bf16(a[2], a[3]); w.z = cvt_pk_bf16(b[0], b[1]); w.w = cvt_pk_bf16(b[2], b[3]); return w; }
__device__ __forceinline__ void unpack8(u32x4 w, f32x4& a, f32x4& b) { a = (f32x4){bf_lo(w.x), bf_hi(w.x), bf_lo(w.y), bf_hi(w.y)}; b = (f32x4){bf_lo(w.z), bf_hi(w.z), bf_lo(w.w), bf_hi(w.w)}; }
__device__ __forceinline__ float fast_rcp(float x) { return __builtin_amdgcn_rcpf(x); }
__device__ __forceinline__ float fast_exp2(float x) { return __builtin_amdgcn_exp2f(x); }
__device__ __forceinline__ float sigmoidf_(float x) { return fast_rcp(1.f + fast_exp2(-1.4426950408889634f * x)); }
__device__ __forceinline__ float wave_sum(float v) {
#pragma unroll
    for (int o = 1; o < 64; o <<= 1) v += __shfl_xor(v, o);
    return v;
}
__device__ __forceinline__ float wave_max(float v) {
#pragma unroll
    for (int o = 1; o < 64; o <<= 1) v = fmaxf(v, __shfl_xor(v, o));
    return v;
}
#define LDS_WAIT() asm volatile("s_waitcnt lgkmcnt(0)" ::: "memory")
__device__ __forceinline__ int fresh_bid() { int b = blockIdx.x; asm volatile("" : "+s"(b)); return b; }
__device__ __forceinline__ int fresh_tid() { int t = threadIdx.x; asm volatile("" : "+v"(t)); return t; }

namespace pg8 {
constexpr int BM = 256, BK = 64, HALF = 128, HTB = HALF * BK * 2, STAGE_BYTES = 8 * HTB, NXCD = 8, WGM = 8;
__host__ __device__ __forceinline__ int lds_byte(int r, int c) { const int st = (r >> 4) * 2 + (c >> 5), rr = r & 15, cc = c & 31, ob = rr * 64 + cc * 2; return st * 1024 + (ob ^ (((ob >> 9) & 1) << 5)); }
__host__ __device__ __forceinline__ void stage_rc(int b, int& R, int& C) { const int st = b / 1024, sb = b % 1024, swz = sb ^ (((sb >> 9) & 1) << 5); R = (st >> 1) * 16 + swz / 64; C = (st & 1) * 32 + (swz % 64) / 2; }
__host__ __device__ __forceinline__ int perm32(int rho) { const int n = rho >> 4, i = rho & 15; return 8 * (i >> 2) + 4 * n + (i & 3); }

struct Unit { int pm, pn; };
struct Gemm { const bf16_t* A; const bf16_t* Bt; int M, N, K; };

struct StaticOrder {
    int nM, nN, nwg, G, c;
    __device__ void init(int M, int N, int G_, int c_) { nM = M / BM; nN = N / BM; nwg = nM * nN; G = G_; c = c_; }
    __device__ bool next(int i, Unit& u) const {
        const long L = (long)i * G + c; if (L >= nwg) return false;
        int wgid = (int)L; { const int q = nwg / NXCD, r = nwg % NXCD, xcd = wgid % NXCD, off = wgid / NXCD; wgid = (xcd < r ? xcd * (q + 1) : r * (q + 1) + (xcd - r) * q) + off; }
        const int nig = WGM * nN, gid = wgid / nig, fm = gid * WGM, gsz = (nM - fm) < WGM ? (nM - fm) : WGM;
        u.pm = fm + ((wgid % nig) % gsz); u.pn = (wgid % nig) / gsz; return true;
    }
    __device__ __forceinline__ void a_ready(const Unit&) const {}
    __device__ __forceinline__ void done(const Unit&) const {}
};

template <class Epi, class Sched, bool ALIGN_EPI = false, bool SP2 = false>
__device__ __forceinline__ void gemm_phase(LAS unsigned char* lds, const Gemm g, const Sched& S, const Epi& E) {
    const int tid = fresh_tid(), wid = __builtin_amdgcn_readfirstlane(tid >> 6), lane = tid & 63, wr = wid >> 2, wc = wid & 3, fr = lane & 15, fq = lane >> 4;
    const int K = g.K, nt = K / BK;
    unsigned voffA[2], voffB[2];
#pragma unroll
    for (int i = 0; i < 2; ++i) { int R, C; stage_rc(tid * 16 + i * 8192, R, C); const int Rb = Epi::PERM ? ((R & ~31) + perm32(R & 31)) : R;
        voffA[i] = (unsigned)(R * K + C) * 2u; voffB[i] = (unsigned)(Rb * K + C) * 2u; }
    const size_t kstep = (size_t)(BK * 2);
    const size_t hstep = (size_t)HALF * K * 2;
    const size_t tstep = 2 * hstep;
    const unsigned ldsw = (unsigned)wid * 1024u;
    const int aoff = lds_byte(wr * 64 + fr, fq * 8), boff = lds_byte(wc * 32 + fr, fq * 8);
#define PG8_SA(b, h) (((b) * 2 + (h)) * HTB)
#define PG8_SB(b, h) ((4 + (b) * 2 + (h)) * HTB)
#define PG8_STAGE(bufoff, gbase, voff) do { _Pragma("unroll") for (int _i = 0; _i < 2; ++_i) \
        __builtin_amdgcn_global_load_lds((const unsigned*)((const char*)(gbase) + (voff)[_i]), (LAS unsigned*)(lds + (bufoff) + ldsw + _i * 8192), 16, 0, 0); } while (0)
#define PG8_LDA(dst, b, h) do { _Pragma("unroll") for (int m = 0; m < 4; ++m) _Pragma("unroll") for (int k = 0; k < 2; ++k) dst[m][k] = *(const LAS bf16x8*)(lds + PG8_SA(b, h) + aoff + m * 2048 + k * 1024); } while (0)
#define PG8_LDB(dst, b, h) do { _Pragma("unroll") for (int n = 0; n < 2; ++n) _Pragma("unroll") for (int k = 0; k < 2; ++k) dst[n][k] = *(const LAS bf16x8*)(lds + PG8_SB(b, h) + boff + n * 2048 + k * 1024); } while (0)
#define PG8_MMA(ai, bj, At, Bt) do { __builtin_amdgcn_s_setprio(1); _Pragma("unroll") for (int m = 0; m < 4; ++m) _Pragma("unroll") for (int n = 0; n < 2; ++n) _Pragma("unroll") for (int k = 0; k < 2; ++k) \
        acc[ai][bj][m][n] = __builtin_amdgcn_mfma_f32_16x16x32_bf16(Bt[n][k], At[m][k], acc[ai][bj][m][n], 0, 0, 0); __builtin_amdgcn_s_setprio(0); } while (0)
#define PG8_WAIT_V(n) asm volatile("s_waitcnt vmcnt(" #n ")" ::: "memory")
#define PG8_WAIT_L(n) asm volatile("s_waitcnt lgkmcnt(" #n ")" ::: "memory")
#define PG8_BAR __builtin_amdgcn_s_barrier()
#define PG8_SCHED __builtin_amdgcn_sched_barrier(0)
    Unit cur, nxt; int ui = 0;
    if (!S.next(0, cur)) return;
    f32x4 acc[2][2][4][2];
#pragma unroll
    for (int a = 0; a < 2; ++a)
#pragma unroll
        for (int b = 0; b < 2; ++b)
#pragma unroll
            for (int m = 0; m < 4; ++m)
#pragma unroll
                for (int n = 0; n < 2; ++n) acc[a][b][m][n] = (f32x4){0.f, 0.f, 0.f, 0.f};
    bf16x8 At[4][2], B0[2][2], B1[2][2];
    const char* cA = (const char*)g.A + (size_t)cur.pm * tstep; const char* cB = (const char*)g.Bt + (size_t)cur.pn * tstep;
    S.a_ready(cur);
    if constexpr (SP2) {
        PG8_STAGE(PG8_SB(0, 0), cB, voffB); PG8_STAGE(PG8_SB(0, 1), cB + hstep, voffB); PG8_STAGE(PG8_SA(0, 0), cA, voffA); PG8_STAGE(PG8_SA(0, 1), cA + hstep, voffA);
        if (wr == 1) PG8_BAR;
        PG8_WAIT_V(2); PG8_BAR;
        PG8_STAGE(PG8_SB(1, 0), cB + kstep, voffB); PG8_STAGE(PG8_SA(1, 0), cA + kstep, voffA); PG8_STAGE(PG8_SB(1, 1), cB + hstep + kstep, voffB);
        PG8_WAIT_V(6); PG8_BAR;
    } else {
        PG8_STAGE(PG8_SB(0, 0), cB, voffB); PG8_STAGE(PG8_SA(0, 0), cA, voffA); PG8_STAGE(PG8_SB(0, 1), cB + hstep, voffB); PG8_STAGE(PG8_SA(0, 1), cA + hstep, voffA);
        if (wr == 1) PG8_BAR;
        PG8_WAIT_V(4); PG8_BAR;
        PG8_STAGE(PG8_SB(1, 0), cB + kstep, voffB); PG8_STAGE(PG8_SA(1, 0), cA + kstep, voffA); PG8_STAGE(PG8_SB(1, 1), cB + hstep + kstep, voffB);
        PG8_WAIT_V(6); PG8_BAR;
    }
    for (;;) {
        const bool has_next = S.next(ui + 1, nxt);
        const char* nA = has_next ? (const char*)g.A + (size_t)nxt.pm * tstep : cA; const char* nB = has_next ? (const char*)g.Bt + (size_t)nxt.pn * tstep : cB;
        for (int t = 0; t < nt; t += 2) {
            const bool last = (t == nt - 2);
            const char* a1 = cA + (size_t)(t + 1) * kstep;
            const char* a2 = last ? nA : cA + (size_t)(t + 2) * kstep; const char* b2 = last ? nB : cB + (size_t)(t + 2) * kstep;
            const char* a3 = a2 + kstep; const char* b3 = b2 + kstep;
            if (last && has_next) S.a_ready(nxt);
            if constexpr (SP2) {
            PG8_LDB(B0, 0, 0); PG8_LDB(B1, 0, 1); PG8_SCHED; PG8_LDA(At, 0, 0); PG8_STAGE(PG8_SA(1, 1), a1 + hstep, voffA);
            PG8_WAIT_V(8); PG8_WAIT_L(0); PG8_BAR; PG8_MMA(0, 0, At, B0); PG8_MMA(0, 1, At, B1); PG8_BAR; PG8_SCHED;
            PG8_LDA(At, 0, 1); PG8_STAGE(PG8_SB(0, 0), b2, voffB); PG8_STAGE(PG8_SB(0, 1), b2 + hstep, voffB); PG8_STAGE(PG8_SA(0, 0), a2, voffA);
            PG8_WAIT_V(8); PG8_WAIT_L(0); PG8_BAR; PG8_MMA(1, 0, At, B0); PG8_MMA(1, 1, At, B1); PG8_BAR; PG8_SCHED;
            PG8_LDB(B0, 1, 0); PG8_LDB(B1, 1, 1); PG8_SCHED; PG8_LDA(At, 1, 0); PG8_STAGE(PG8_SA(0, 1), a2 + hstep, voffA);
            PG8_WAIT_V(8); PG8_WAIT_L(0); PG8_BAR; PG8_MMA(0, 0, At, B0); PG8_MMA(0, 1, At, B1); PG8_BAR; PG8_SCHED;
            PG8_LDA(At, 1, 1); PG8_STAGE(PG8_SB(1, 0), b3, voffB); PG8_STAGE(PG8_SB(1, 1), b3 + hstep, voffB); PG8_STAGE(PG8_SA(1, 0), a3, voffA);
            PG8_WAIT_V(8); PG8_WAIT_L(0); PG8_BAR; PG8_MMA(1, 0, At, B0); PG8_MMA(1, 1, At, B1); PG8_BAR; PG8_SCHED;
            } else {
            PG8_LDB(B0, 0, 0); PG8_SCHED; PG8_LDA(At, 0, 0); PG8_STAGE(PG8_SA(1, 1), a1 + hstep, voffA);
            PG8_WAIT_L(8); PG8_BAR; PG8_WAIT_L(0); PG8_MMA(0, 0, At, B0); PG8_BAR; PG8_SCHED;
            PG8_LDB(B1, 0, 1); PG8_STAGE(PG8_SB(0, 0), b2, voffB);
            PG8_BAR; PG8_WAIT_L(0); PG8_MMA(0, 1, At, B1); PG8_BAR;
            PG8_LDA(At, 0, 1); PG8_STAGE(PG8_SA(0, 0), a2, voffA);
            PG8_BAR; PG8_WAIT_L(0); PG8_MMA(1, 0, At, B0); PG8_BAR; PG8_SCHED;
            PG8_STAGE(PG8_SB(0, 1), b2 + hstep, voffB);
            PG8_WAIT_V(6); PG8_BAR; PG8_MMA(1, 1, At, B1); PG8_BAR;
            PG8_LDB(B0, 1, 0); PG8_SCHED; PG8_LDA(At, 1, 0); PG8_STAGE(PG8_SA(0, 1), a2 + hstep, voffA);
            PG8_WAIT_L(8); PG8_BAR; PG8_WAIT_L(0); PG8_MMA(0, 0, At, B0); PG8_BAR; PG8_SCHED;
            PG8_LDB(B1, 1, 1); PG8_STAGE(PG8_SB(1, 0), b3, voffB);
            PG8_BAR; PG8_WAIT_L(0); PG8_MMA(0, 1, At, B1); PG8_BAR;
            PG8_LDA(At, 1, 1); PG8_STAGE(PG8_SA(1, 0), a3, voffA);
            PG8_BAR; PG8_WAIT_L(0); PG8_MMA(1, 0, At, B0); PG8_BAR; PG8_SCHED;
            PG8_STAGE(PG8_SB(1, 1), b3 + hstep, voffB);
            PG8_WAIT_V(6); PG8_BAR; PG8_MMA(1, 1, At, B1); PG8_BAR;
            }
        }
        if constexpr (ALIGN_EPI) { if (wr == 0) PG8_BAR; }
        if constexpr (!Epi::AFTER_DRAIN) { E(acc, cur, wr, wc, fr, fq); S.done(cur); }
        if (!has_next) break;
#pragma unroll
        for (int a = 0; a < 2; ++a)
#pragma unroll
            for (int b = 0; b < 2; ++b)
#pragma unroll
                for (int m = 0; m < 4; ++m)
#pragma unroll
                    for (int n = 0; n < 2; ++n) acc[a][b][m][n] = (f32x4){0.f, 0.f, 0.f, 0.f};
        cur = nxt; cA = nA; cB = nB; ++ui;
        if constexpr (ALIGN_EPI) { if (wr == 1) PG8_BAR; }
    }
    PG8_WAIT_V(0);
    if constexpr (!ALIGN_EPI) { if (wr == 0) PG8_BAR; }
    PG8_BAR;
#undef PG8_SA
#undef PG8_SB
#undef PG8_STAGE
#undef PG8_LDA
#undef PG8_LDB
#undef PG8_MMA
#undef PG8_WAIT_V
#undef PG8_WAIT_L
#undef PG8_BAR
#undef PG8_SCHED
}
}

typedef f32x4 Acc[2][2][4][2];

#define AG_LD(p) __hip_atomic_load((p), __ATOMIC_RELAXED, __HIP_MEMORY_SCOPE_AGENT)
#define AG_ST(p, v) __hip_atomic_store((p), (v), __ATOMIC_RELAXED, __HIP_MEMORY_SCOPE_AGENT)
__device__ __forceinline__ float row_ss4(const float* rss, int row, int fq) {
    const f32x4 v = *(const f32x4*)(rss + ((size_t)fq * MPAD + row) * 4);
    return (v[0] + v[1]) + (v[2] + v[3]);
}
__device__ __forceinline__ void rows_inv(const float* rss, int row0, int fq, float (&inv)[2][4]) {
#pragma unroll
    for (int ai = 0; ai < 2; ++ai)
#pragma unroll
        for (int m = 0; m < 4; ++m) inv[ai][m] = row_ss4(rss, row0 + ai * 128 + m * 16, fq);
#pragma unroll
    for (int ai = 0; ai < 2; ++ai)
#pragma unroll
        for (int m = 0; m < 4; ++m) { float s = inv[ai][m]; s += __shfl_xor(s, 16); s += __shfl_xor(s, 32); inv[ai][m] = __builtin_amdgcn_rsqf(s * (1.0f / 1024.0f) + RMS_EPS); }
}

struct EpiSwiGLU {
    static constexpr bool PERM = true, AFTER_DRAIN = false;
    bf16_t* act; const float* rss;
    __device__ __forceinline__ void operator()(const Acc& acc, const pg8::Unit& u, int wr, int wc, int fr, int fq) const {
        const int row0 = u.pm * 256 + wr * 64 + fr, col = u.pn * 128 + wc * 32 + 8 * fq;
        float invs[2][4]; rows_inv(rss, row0, fq, invs);
#pragma unroll
        for (int ai = 0; ai < 2; ++ai)
#pragma unroll
            for (int m = 0; m < 4; ++m) {
                const int row = row0 + ai * 128 + m * 16; const float inv = invs[ai][m];
                f32x4 o[2];
#pragma unroll
                for (int n = 0; n < 2; ++n) { const f32x4 gt = acc[ai][0][m][n] * inv, up = acc[ai][1][m][n] * inv;
#pragma unroll
                    for (int j = 0; j < 4; ++j) o[n][j] = gt[j] * sigmoidf_(gt[j]) * up[j]; }
                *(u32x4*)(act + (size_t)row * DFF + col) = pack8(o[0], o[1]);
            }
    }
};

struct EpiResid {
    static constexpr bool PERM = true, AFTER_DRAIN = false;
    float* xres; bf16_t* xb; float* rss; float scale;
    __device__ __forceinline__ void operator()(const Acc& acc, const pg8::Unit& u, int wr, int wc, int fr, int fq) const {
        const int row0 = u.pm * 256 + wr * 64 + fr, col0 = u.pn * 256 + wc * 32 + 8 * fq;
#pragma unroll
        for (int ai = 0; ai < 2; ++ai)
#pragma unroll
            for (int m = 0; m < 4; ++m) {
                const int row = row0 + ai * 128 + m * 16; float ss = 0.f;
#pragma unroll
                for (int bj = 0; bj < 2; ++bj) {
                    float* p = xres + (size_t)row * DM + col0 + bj * 128;
                    f32x4 r0 = *(const f32x4*)p, r1 = *(const f32x4*)(p + 4);
                    r0 += acc[ai][bj][m][0] * scale; r1 += acc[ai][bj][m][1] * scale;
                    *(f32x4*)p = r0; *(f32x4*)(p + 4) = r1;
                    *(u32x4*)(xb + (size_t)row * DM + col0 + bj * 128) = pack8(r0, r1);
                    ss += (r0[0] * r0[0] + r0[1] * r0[1]) + (r0[2] * r0[2] + r0[3] * r0[3]) + (r1[0] * r1[0] + r1[1] * r1[1]) + (r1[2] * r1[2] + r1[3] * r1[3]);
                }
                ss += __shfl_xor(ss, 16); ss += __shfl_xor(ss, 32);
                if (fq == 0) rss[((size_t)u.pn * MPAD + row) * 4 + wc] = ss;
                if (m & 1) asm volatile("" ::: "memory");
            }
    }
};

struct EpiMixA {
    static constexpr bool PERM = true, AFTER_DRAIN = false;
    const bf16_t* gates; float* mtmp;
    __device__ __forceinline__ void operator()(const Acc& acc, const pg8::Unit& u, int wr, int wc, int fr, int fq) const {
        const int row0 = u.pm * 256 + wr * 64 + fr, col0 = u.pn * 256 + wc * 32 + 8 * fq;
#pragma unroll
        for (int ai = 0; ai < 2; ++ai)
#pragma unroll
            for (int m = 0; m < 4; ++m) {
                const int row = row0 + ai * 128 + m * 16;
#pragma unroll
                for (int bj = 0; bj < 2; ++bj) {
                    const int col = col0 + bj * 128; f32x4 g0, g1; unpack8(*(const u32x4*)(gates + (size_t)row * 2048 + col), g0, g1);
                    float* p = mtmp + (size_t)row * DM + col;
                    *(f32x4*)p = acc[ai][bj][m][0] * g0 * ABL_A; *(f32x4*)(p + 4) = acc[ai][bj][m][1] * g1 * ABL_A;
                    if (bj == 1) asm volatile("" ::: "memory");
                }
            }
    }
};
struct EpiMixB {
    static constexpr bool PERM = true, AFTER_DRAIN = false;
    const bf16_t* gates; const float* mtmp; bf16_t* mo;
    __device__ __forceinline__ void operator()(const Acc& acc, const pg8::Unit& u, int wr, int wc, int fr, int fq) const {
        const int row0 = u.pm * 256 + wr * 64 + fr, col0 = u.pn * 256 + wc * 32 + 8 * fq;
#pragma unroll
        for (int ai = 0; ai < 2; ++ai)
#pragma unroll
            for (int m = 0; m < 4; ++m) {
                const int row = row0 + ai * 128 + m * 16;
#pragma unroll
                for (int bj = 0; bj < 2; ++bj) {
                    const int col = col0 + bj * 128; f32x4 g0, g1; unpack8(*(const u32x4*)(gates + (size_t)row * 2048 + 1024 + col), g0, g1);
                    const float* p = mtmp + (size_t)row * DM + col;
                    const f32x4 r0 = *(const f32x4*)p + acc[ai][bj][m][0] * g0 * ABL_C, r1 = *(const f32x4*)(p + 4) + acc[ai][bj][m][1] * g1 * ABL_C;
                    *(u32x4*)(mo + (size_t)row * DM + col) = pack8(r0, r1);
                    if (bj == 1) asm volatile("" ::: "memory");
                }
            }
    }
};

struct EpiProj {
    static constexpr bool PERM = true, AFTER_DRAIN = false;
    unsigned char* ws; const float* bgate; float* out; int layer;
    __device__ __forceinline__ void operator()(const Acc& acc, const pg8::Unit& u, int wr, int wc, int fr, int fq) const {
        const int row0 = u.pm * 256 + wr * 64 + fr, lc = wc * 32 + 8 * fq, pn = u.pn;
        const float* rss = (const float*)(ws + WS_RSS); bf16_t* cb = (bf16_t*)(ws + WS_CB); bf16_t* zc = (bf16_t*)(ws + WS_ZC); bf16_t* gates = (bf16_t*)(ws + WS_GATES);
        float invs[2][4]; rows_inv(rss, row0, fq, invs);
        if (pn < 18) {
            const int sel = pn / 6, ct = pn - sel * 6, g = ct >> 1, keep = 128 << (2 * g);
            bf16_t* dst = (bf16_t*)(ws + WS_Q + (size_t)sel * (WS_K - WS_Q)); const float sc = sel == 0 ? QSCALE : 1.f;
            const size_t okp = g == 0 ? O_KVP0 : (g == 1 ? O_KVP1 : O_KVP2), oks = g == 0 ? O_KVS0 : (g == 1 ? O_KVS1 : O_KVS2);
#pragma unroll
            for (int ai = 0; ai < 2; ++ai)
#pragma unroll
                for (int m = 0; m < 4; ++m) {
                    const int row = row0 + ai * 128 + m * 16; const float s = invs[ai][m] * sc;
                    float* o = nullptr;
                    if (sel > 0) {
                        if (row < MP) { const int b = row >> 13, pos = row & 8191; if (pos >= SEQ - keep) o = out + okp + (((size_t)(layer * 2 + b) * keep + (pos - (SEQ - keep))) * 2 + (sel - 1)) * 512; }
                        else if (row < MV) { const int sr = row - MP, bd = sr >> 2, t = sr & 3; o = out + oks + (((size_t)(layer * 32 + bd) * keep + (keep - 4 + t)) * 2 + (sel - 1)) * 512; }
                    }
#pragma unroll
                    for (int bj = 0; bj < 2; ++bj) {
                        const int col = ct * 256 + bj * 128 + lc; const f32x4 v0 = acc[ai][bj][m][0] * s, v1 = acc[ai][bj][m][1] * s;
                        *(u32x4*)(dst + (size_t)row * NQKV + col) = pack8(v0, v1);
                        if (o) { float* p = o + (col & 511); *(f32x4*)p = v0; *(f32x4*)(p + 4) = v1; }
                    }
                }
        } else if (pn < 22) {
            const int ct = pn - 18;
#pragma unroll
            for (int ai = 0; ai < 2; ++ai)
#pragma unroll
                for (int m = 0; m < 4; ++m) {
                    const int row = row0 + ai * 128 + m * 16; const float s = invs[ai][m];
#pragma unroll
                    for (int bj = 0; bj < 2; ++bj) *(u32x4*)(cb + (size_t)row * DM + ct * 256 + bj * 128 + lc) = pack8(acc[ai][bj][m][0] * s, acc[ai][bj][m][1] * s);
                }
        } else if (pn < 30) {
            const int col = (pn - 22) * 128 + lc;
#pragma unroll
            for (int ai = 0; ai < 2; ++ai)
#pragma unroll
                for (int m = 0; m < 4; ++m) {
                    const int row = row0 + ai * 128 + m * 16; const float s = invs[ai][m];
                    const f32x4 z0 = (acc[ai][0][m][0] * s) * (acc[ai][1][m][0] * s), z1 = (acc[ai][0][m][1] * s) * (acc[ai][1][m][1] * s);
                    *(u32x4*)(zc + (size_t)row * DM + col) = pack8(z0, z1);
                    float* o = nullptr;
                    if (row < MP) { const int b = row >> 13, pos = row & 8191; if (pos >= SEQ - 2) o = out + O_CONVP + ((size_t)(layer * 2 + b) * 2 + (pos - (SEQ - 2))) * 1024; }
                    else if (row < MV) { const int sr = row - MP, bd = sr >> 2, t = sr & 3; if (t >= 2) o = out + O_CONVS + ((size_t)(layer * 32 + bd) * 2 + (t - 2)) * 1024; }
                    if (o) { *(f32x4*)(o + col) = z0; *(f32x4*)(o + col + 4) = z1; }
                }
        } else {
            const int ct = pn - 30;
#pragma unroll
            for (int bj = 0; bj < 2; ++bj) {
                const int col = ct * 256 + bj * 128 + lc; const f32x4 b0 = *(const f32x4*)(bgate + col), b1 = *(const f32x4*)(bgate + col + 4);
#pragma unroll
                for (int ai = 0; ai < 2; ++ai)
#pragma unroll
                    for (int m = 0; m < 4; ++m) {
                        const int row = row0 + ai * 128 + m * 16; const float s = invs[ai][m];
                        f32x4 z0 = acc[ai][bj][m][0] * s + b0, z1 = acc[ai][bj][m][1] * s + b1;
#pragma unroll
                        for (int j = 0; j < 4; ++j) { z0[j] = EXP_SIG(z0[j]); z1[j] = EXP_SIG(z1[j]); }
                        *(u32x4*)(gates + (size_t)row * 2048 + col) = pack8(z0, z1);
                    }
            }
        }
    }
};

__device__ __forceinline__ void transpose_item(const float* W, int K, int Nsrc, const float* gain, bf16_t* WT, int dst_row0, int src_col0, int k0, LAS float* scr, int lane) {
#pragma unroll
    for (int i = 0; i < 32; ++i) { const int kk = 2 * i + (lane >> 5); float w = W[(size_t)(k0 + kk) * Nsrc + src_col0 + (lane & 31)]; if (gain) w *= gain[k0 + kk]; scr[kk * 33 + (lane & 31)] = w; }
    LDS_WAIT();
    const int c = lane & 7;
#pragma unroll
    for (int j = 0; j < 4; ++j) { const int n = (lane >> 3) + 8 * j; const LAS float* s = scr + (8 * c) * 33 + n;
        u32x4 o; o.x = cvt_pk_bf16(s[0 * 33], s[1 * 33]); o.y = cvt_pk_bf16(s[2 * 33], s[3 * 33]); o.z = cvt_pk_bf16(s[4 * 33], s[5 * 33]); o.w = cvt_pk_bf16(s[6 * 33], s[7 * 33]);
        *(u32x4*)(WT + (size_t)(dst_row0 + n) * K + k0 + 8 * c) = o; }
    LDS_WAIT();
}

#define DIAG_W 1024
#define DUMP_GATES_RETURN() do { const int t3 = fresh_tid(); const bf16_t* gsrc = (const bf16_t*)(P.ws + WS_GATES); \
    for (size_t i = (size_t)blockIdx.x * 512 + t3; i < (size_t)MV * DM; i += (size_t)gridDim.x * 512) { const size_t row = i >> 10, col = i & 1023; P.out[i] = bf2f(gsrc[row * 2048 + col]) + 2.f * bf2f(gsrc[row * 2048 + 1024 + col]); } \
    return; } while (0)
#define CHECK_GATES(k) do { if (l == 1) { const int t4 = fresh_tid(); const unsigned* gz = (const unsigned*)(P.ws + WS_GATES); bool bad = false; \
    for (size_t i = (size_t)blockIdx.x * 512 + t4; i < (size_t)MV * 1024; i += (size_t)gridDim.x * 512) { const unsigned w = gz[i]; if (fabsf(bf_lo(w)) > 2.f || fabsf(bf_hi(w)) > 2.f) bad = true; } \
    if (bad) atomicOr((unsigned*)(P.ws + WS_CTL) + 8192, 1u << (k)); } } while (0)
struct Params { const float* in[20]; float* out; unsigned char* ws; int ph_lo, ph_hi; };

constexpr int IT_1I = 16 * 176, IT_1O = 44 * 32, IT_IN = 16 * 304, IT_AO = 8 * 32, IT_CO = 16 * 32, IT_O = 16 * 32, IT_LAYER = 2 * IT_1I + 2 * IT_1O + IT_IN + IT_AO + IT_CO + IT_O;

__device__ __forceinline__ void conv_weights(const Params& P, LAS float* scr, int gw, int ngw, int lane) {
    for (int it = gw; it < NLAYER * IT_LAYER; it += ngw) {
        const int l = it / IT_LAYER; int r = it - l * IT_LAYER;
        unsigned char* wl = P.ws + WS_W + (size_t)l * LW_END;
        if (r < 2 * IT_1I) {
            const int f = r / IT_1I; r -= f * IT_1I; const int kb = r / 176, nb = r % 176, R0 = nb * 32;
            const int src = ((R0 & 255) >> 7) * DFF + (R0 >> 8) * 128 + (R0 & 127);
            transpose_item(P.in[f ? 17 : 7] + (size_t)l * DM * 2 * DFF, DM, 2 * DFF, P.in[f ? 16 : 6] + l * DM, (bf16_t*)(wl + (f ? LW_W2I : LW_W1I)), R0, src, kb * 64, scr, lane);
            continue;
        }
        r -= 2 * IT_1I;
        if (r < 2 * IT_1O) {
            const int f = r / IT_1O; r -= f * IT_1O; const int kb = r / 32, nb = r % 32;
            transpose_item(P.in[f ? 18 : 8] + (size_t)l * DFF * DM, DFF, DM, nullptr, (bf16_t*)(wl + (f ? LW_W2O : LW_W1O)), nb * 32, nb * 32, kb * 64, scr, lane);
            continue;
        }
        r -= 2 * IT_1O;
        if (r < IT_IN) {
            const int kb = r / 304, nb = r % 304, R0 = nb * 32; int src = R0;
            if (R0 >= 5632 && R0 < 7680) { const int x = R0 - 5632; src = 5632 + ((x & 255) >> 7) * 1024 + (x >> 8) * 128 + (x & 127); }
            transpose_item(P.in[10] + (size_t)l * DM * NIN, DM, NIN, P.in[9] + l * DM, (bf16_t*)(wl + LW_WIN), R0, src, kb * 64, scr, lane);
            continue;
        }
        r -= IT_IN;
        if (r < IT_AO) { const int kb = r / 32, nb = r % 32; transpose_item(P.in[13] + (size_t)l * 512 * DM, 512, DM, nullptr, (bf16_t*)(wl + LW_WAO), nb * 32, nb * 32, kb * 64, scr, lane); continue; }
        r -= IT_AO;
        if (r < IT_CO) { const int kb = r / 32, nb = r % 32; transpose_item(P.in[14] + (size_t)l * DM * DM, DM, DM, nullptr, (bf16_t*)(wl + LW_WCO), nb * 32, nb * 32, kb * 64, scr, lane); continue; }
        r -= IT_CO;
        { const int kb = r / 32, nb = r % 32; transpose_item(P.in[15] + (size_t)l * DM * DM, DM, DM, nullptr, (bf16_t*)(wl + LW_WO), nb * 32, nb * 32, kb * 64, scr, lane); }
    }
}

__device__ __forceinline__ void init_x(const Params& P, int gw, int ngw, int lane) {
    float* xres = (float*)(P.ws + WS_XRES); bf16_t* xb = (bf16_t*)(P.ws + WS_XB); float* rss = (float*)(P.ws + WS_RSS);
    for (int row = gw; row < MPAD; row += ngw) {
        f32x4 v[4]; float s = 0.f;
        if (row < MV) {
            const f32x4* src = (const f32x4*)(row < MP ? P.in[0] + (size_t)row * DM : P.in[1] + (size_t)(row - MP) * DM) + lane;
#pragma unroll
            for (int j = 0; j < 4; ++j) { v[j] = src[64 * j]; s += (v[j][0] * v[j][0] + v[j][1] * v[j][1]) + (v[j][2] * v[j][2] + v[j][3] * v[j][3]); }
        } else {
#pragma unroll
            for (int j = 0; j < 4; ++j) v[j] = (f32x4){0.f, 0.f, 0.f, 0.f};
        }
        s = wave_sum(s);
        f32x4* xr = (f32x4*)(xres + (size_t)row * DM) + lane; u32x2* xo = (u32x2*)(xb + (size_t)row * DM) + lane;
#pragma unroll
        for (int j = 0; j < 4; ++j) { xr[64 * j] = v[j]; u32x2 w; w.x = cvt_pk_bf16(v[j][0], v[j][1]); w.y = cvt_pk_bf16(v[j][2], v[j][3]); xo[64 * j] = w; }
        if (lane < 16) rss[((size_t)(lane >> 2) * MPAD + row) * 4 + (lane & 3)] = lane == 0 ? s : 0.f;
    }
}

constexpr size_t CP4_0 = (size_t)124 * 256, CP4_1 = (size_t)508 * 256, CP4_2 = (size_t)2044 * 256;
constexpr size_t CPT_0 = CP4_0 * 64, CPT_1 = CPT_0 + CP4_1 * 64, CPT_2 = CPT_1 + CP4_2 * 64;
constexpr size_t CP_ATT_PER_UNIT = 1024, CP_ATT_N = (size_t)NLAYER * 3072 * CP_ATT_PER_UNIT, CP_DED_N = (size_t)NLAYER * 3072 * 2048, CP_DED2_N = (size_t)NLAYER * 3072 * 512, CP_DED3_N = (size_t)NLAYER * 3072 * 512, CP_REST_BEGIN = CP_ATT_N + CP_DED_N + CP_DED2_N + CP_DED3_N;
constexpr int COPY_UNITS = 20;
static_assert(CP_REST_BEGIN < CPT_2 && CP_ATT_N % 256 == 0 && CP_DED_N % 1024 == 0 && CP_DED2_N % 512 == 0, "copy split");
__device__ __forceinline__ void copy_addr(const Params& P, size_t i, const f32x4*& src, f32x4*& dst) {
    const int g = i < CPT_0 ? 0 : (i < CPT_1 ? 1 : 2);
    const size_t j = i - (g == 0 ? 0 : (g == 1 ? CPT_0 : CPT_1)), chunk4 = g == 0 ? CP4_0 : (g == 1 ? CP4_1 : CP4_2), keep4 = chunk4 + 1024;
    const size_t c = j / chunk4, o = j - c * chunk4;
    src = (const f32x4*)P.in[2 + g] + c * keep4 + 1024 + o; dst = (f32x4*)(P.out + (g == 0 ? O_KVS0 : (g == 1 ? O_KVS1 : O_KVS2))) + c * keep4 + o;
}
__device__ __forceinline__ void copy_part(const Params& P, int ubeg, int ucnt) {
    const int bx = fresh_bid();
    if (bx < 4) return;
    constexpr size_t REST = CPT_2 - CP_REST_BEGIN;
    const size_t b = CP_REST_BEGIN + REST * (size_t)ubeg / COPY_UNITS, e = CP_REST_BEGIN + REST * (size_t)(ubeg + ucnt) / COPY_UNITS;
    const size_t stride = (size_t)(gridDim.x - 4) * 512;
    for (size_t i = b + (size_t)((bx - 4) * 512 + fresh_tid()); i < e; i += stride) {
        const f32x4* src; f32x4* dst; copy_addr(P, i, src, dst);
        __builtin_nontemporal_store(__builtin_nontemporal_load(src), dst);
    }
}

constexpr int FFN_UP_GRID = 240;
constexpr int PROJ_GRID = 247;
__device__ __forceinline__ void copy_dedicated(const Params& P, size_t rb, size_t re, int first_block) {
    const int tid = fresh_tid(), lane = tid & 63, wgl = (fresh_bid() - first_block) * 8 + (tid >> 6), nw = ((int)gridDim.x - first_block) * 8;
    for (size_t r0 = rb + (size_t)wgl * 4; r0 < re; r0 += (size_t)nw * 4) {
        f32x4 val[4][4]; f32x4* dstp[4];
#pragma unroll
        for (int u = 0; u < 4; ++u) { const size_t r = r0 + u < re ? r0 + u : re - 1; const f32x4* src; copy_addr(P, r * 256, src, dstp[u]);
#pragma unroll
            for (int qq = 0; qq < 4; ++qq) val[u][qq] = __builtin_nontemporal_load(src + qq * 64 + lane); }
#pragma unroll
        for (int u = 0; u < 4; ++u)
#pragma unroll
            for (int qq = 0; qq < 4; ++qq) __builtin_nontemporal_store(val[u][qq], dstp[u] + qq * 64 + lane);
    }
}

__device__ __forceinline__ void attn_prompt(LAS unsigned char* lds, const Params& P, int layer, const bf16_t* q, const bf16_t* k, const bf16_t* v, bf16_t* og, float* lse) {
    const int tid = fresh_tid();
    const int wid = tid >> 6, lane = tid & 63, fr = lane & 15, fq = lane >> 4, i0 = 16 * wid;
    LAS unsigned char* Ks = lds;
    LAS unsigned char* Vt = lds + 36864;
    const int G = gridDim.x;
    u32x4 kreg[4], va[2], vb[2]; bf16x8 qfN[2]; int nN, gN, hN; size_t qrowN;
#define ATT_LOAD(unit_) do { const int u_ = (unit_); const int b = u_ / 1536; int rem = u_ - b * 1536; gN = rem >> 9; rem &= 511; hN = rem >> 6; const int x = rem & 63; \
        const int dsh = 2 * gN, d = 1 << dsh, r = x & (d - 1); nN = x >> dsh; const int colbase = gN * 512 + hN * 64; const size_t rowbase = (size_t)b * SEQ; \
        _Pragma("unroll") for (int i = 0; i < 4; ++i) { const int c = tid + 512 * i, key = c >> 3, part = c & 7, uu = nN * 128 - 128 + key; \
            kreg[i] = (u32x4){0u, 0u, 0u, 0u}; if (uu >= 0) kreg[i] = *(const u32x4*)(k + (rowbase + (size_t)uu * d + r) * NQKV + colbase + part * 8); } \
        _Pragma("unroll") for (int i = 0; i < 2; ++i) { const int it = tid + 512 * i, pair = it & 127, part = it >> 7, u0 = nN * 128 - 128 + 2 * pair; \
            va[i] = (u32x4){0u, 0u, 0u, 0u}; vb[i] = (u32x4){0u, 0u, 0u, 0u}; \
            if (u0 >= 0) { va[i] = *(const u32x4*)(v + (rowbase + (size_t)u0 * d + r) * NQKV + colbase + part * 8); vb[i] = *(const u32x4*)(v + (rowbase + (size_t)(u0 + 1) * d + r) * NQKV + colbase + part * 8); } } \
        qrowN = rowbase + (size_t)(nN * 128 + i0 + fr) * d + r; \
        _Pragma("unroll") for (int ks = 0; ks < 2; ++ks) qfN[ks] = *(const bf16x8*)(q + qrowN * NQKV + colbase + 32 * ks + 8 * fq); } while (0)
    int unit = blockIdx.x;
    if (unit >= 3072) return;
    ATT_LOAD(unit);
    for (;;) {
        const int n = nN, g = gN, h = hN; const size_t qrow = qrowN; bf16x8 qf[2]; qf[0] = qfN[0]; qf[1] = qfN[1];
        __syncthreads();
#pragma unroll
        for (int i = 0; i < 4; ++i) { const int c = tid + 512 * i, key = c >> 3, part = c & 7; *(LAS u32x4*)(Ks + key * 144 + part * 16) = kreg[i]; }
#pragma unroll
        for (int i = 0; i < 2; ++i) { const int it = tid + 512 * i, pair = it & 127, part = it >> 7;
#pragma unroll
            for (int j = 0; j < 4; ++j) {
                const unsigned wa = va[i][j], wb = vb[i][j];
                *(LAS unsigned*)(Vt + (part * 8 + 2 * j) * 528 + pair * 4) = (wa & 0xffffu) | (wb << 16);
                *(LAS unsigned*)(Vt + (part * 8 + 2 * j + 1) * 528 + pair * 4) = (wa >> 16) | (wb & 0xffff0000u);
            } }
        __syncthreads();
        const int unitN = unit + G; const bool hasN = unitN < 3072;
        if (hasN) ATT_LOAD(unitN);
        f32x4 cpv[2];
#pragma unroll
        for (int i = 0; i < 2; ++i) { const f32x4* src; f32x4* dst; copy_addr(P, ((size_t)layer * 3072 + unit) * CP_ATT_PER_UNIT + i * 512 + tid, src, dst); cpv[i] = __builtin_nontemporal_load(src); }
        f32x4 s[9];
#pragma unroll
        for (int t = 0; t < 9; ++t) { s[t] = (f32x4){0.f, 0.f, 0.f, 0.f};
#pragma unroll
            for (int ks = 0; ks < 2; ++ks) { const bf16x8 kf = *(const LAS bf16x8*)(Ks + (i0 + 16 * t + fr) * 144 + (32 * ks + 8 * fq) * 2);
                s[t] = __builtin_amdgcn_mfma_f32_16x16x32_bf16(kf, qf[ks], s[t], 0, 0, 0); } }
        float mx = -1e30f;
#pragma unroll
        for (int t = 0; t < 9; ++t)
#pragma unroll
            for (int j = 0; j < 4; ++j) { const int rel = 16 * t + 4 * fq + j - fr, kk = i0 + 16 * t + 4 * fq + j;
                const bool valid = rel >= 0 && rel <= 128 && (n > 0 || kk >= 128);
                const float sv = valid ? s[t][j] : -1e30f; s[t][j] = sv; mx = fmaxf(mx, sv); }
        mx = fmaxf(mx, __shfl_xor(mx, 16)); mx = fmaxf(mx, __shfl_xor(mx, 32));
        float l = 0.f;
#pragma unroll
        for (int t = 0; t < 9; ++t)
#pragma unroll
            for (int j = 0; j < 4; ++j) { const float p = fast_exp2(s[t][j] - mx); s[t][j] = p; l += p; }
        l += __shfl_xor(l, 16); l += __shfl_xor(l, 32);
        bf16x8 pf[5];
#pragma unroll
        for (int c = 0; c < 5; ++c) { u32x4 w; w.x = cvt_pk_bf16(s[2 * c][0], s[2 * c][1]); w.y = cvt_pk_bf16(s[2 * c][2], s[2 * c][3]);
            if (c < 4) { w.z = cvt_pk_bf16(s[2 * c + 1][0], s[2 * c + 1][1]); w.w = cvt_pk_bf16(s[2 * c + 1][2], s[2 * c + 1][3]); } else { w.z = 0u; w.w = 0u; }
            pf[c] = __builtin_bit_cast(bf16x8, w); }
        const float invl = fast_rcp(l);
#pragma unroll
        for (int dt = 0; dt < 4; ++dt) { f32x4 o = (f32x4){0.f, 0.f, 0.f, 0.f};
#pragma unroll
            for (int c = 0; c < 5; ++c) { const LAS unsigned char* vp = Vt + (16 * dt + fr) * 528 + (i0 + 32 * c + 4 * fq) * 2;
                const u32x2 lo = *(const LAS u32x2*)vp; u32x2 hi = (u32x2){0u, 0u}; if (c < 4) hi = *(const LAS u32x2*)(vp + 32);
                const u32x4 w = (u32x4){lo.x, lo.y, hi.x, hi.y};
                o = __builtin_amdgcn_mfma_f32_16x16x32_bf16(__builtin_bit_cast(bf16x8, w), pf[c], o, 0, 0, 0); }
            u32x2 w; w.x = cvt_pk_bf16(o[0] * invl, o[1] * invl); w.y = cvt_pk_bf16(o[2] * invl, o[3] * invl);
            *(u32x2*)(og + ((size_t)g * MPAD + qrow) * 512 + h * 64 + 16 * dt + 4 * fq) = w; }
        if (fq == 0) AG_ST(lse + qrow * 24 + g * 8 + h, mx + __builtin_amdgcn_logf(l));
#pragma unroll
        for (int i = 0; i < 2; ++i) { const f32x4* src; f32x4* dst; copy_addr(P, ((size_t)layer * 3072 + unit) * CP_ATT_PER_UNIT + i * 512 + tid, src, dst); __builtin_nontemporal_store(cpv[i], dst); }
        if (!hasN) break;
        unit = unitN;
    }
#undef ATT_LOAD
}

__device__ __forceinline__ void attn_sample(LAS unsigned char* lds, const Params& P, int layer, const bf16_t* q, const bf16_t* k, const bf16_t* v, bf16_t* og, float* lse) {
    const int tid = fresh_tid();
    const int wid = tid >> 6, lane = tid & 63, ksub = lane >> 4, d4 = lane & 15;
    LAS float* sp = (LAS float*)(lds + 73728 + wid * 1024);
    for (int task = blockIdx.x * 8 + wid; task < 3072; task += gridDim.x * 8) {
        const int bd = task / 96; int rem = task - bd * 96; const int t = rem / 24, gh = rem - t * 24, g = gh >> 3, h = gh & 7;
        const int d = 1 << (2 * g), lb = 128 << (2 * g); const int row = MP + bd * 4 + t, colbase = g * 512 + h * 64;
        const float* cache = P.in[2 + g] + (size_t)(layer * 32 + bd) * lb * 1024 + h * 64 + 4 * d4;
        const bf16_t* knew = k + (size_t)(MP + bd * 4) * NQKV + colbase + 4 * d4; const bf16_t* vnew = v + (size_t)(MP + bd * 4) * NQKV + colbase + 4 * d4;
        f32x4 q4; { const u32x2 w = *(const u32x2*)(q + (size_t)row * NQKV + colbase + 4 * d4); q4 = (f32x4){bf_lo(w.x), bf_hi(w.x), bf_lo(w.y), bf_hi(w.y)}; }
        LDS_WAIT();
#pragma unroll 1
        for (int bt = 0; bt < 3; ++bt) {
            f32x4 kv[11];
#pragma unroll
            for (int i = 0; i < 11; ++i) { const int j = 4 * (bt * 11 + i) + ksub; kv[i] = (f32x4){0.f, 0.f, 0.f, 0.f};
                if (j <= 128) { const int idx = lb + t - d * j;
                    if (idx >= lb) { const u32x2 w = *(const u32x2*)(knew + (size_t)(idx - lb) * NQKV); kv[i] = (f32x4){bf_lo(w.x), bf_hi(w.x), bf_lo(w.y), bf_hi(w.y)}; }
                    else kv[i] = *(const f32x4*)(cache + (size_t)idx * 1024); } }
#pragma unroll
            for (int i = 0; i < 11; ++i) { const int j = 4 * (bt * 11 + i) + ksub;
                float pd = (kv[i][0] * q4[0] + kv[i][1] * q4[1]) + (kv[i][2] * q4[2] + kv[i][3] * q4[3]);
                pd += __shfl_xor(pd, 1); pd += __shfl_xor(pd, 2); pd += __shfl_xor(pd, 4); pd += __shfl_xor(pd, 8);
                if (d4 == 0 && j <= 128) sp[j] = pd; }
        }
        LDS_WAIT();
        const float s0 = sp[lane], s1 = sp[lane + 64], s2 = lane == 0 ? sp[128] : -1e30f;
        const float mx = wave_max(fmaxf(s0, fmaxf(s1, s2)));
        const float p0 = fast_exp2(s0 - mx), p1 = fast_exp2(s1 - mx), p2 = lane == 0 ? fast_exp2(s2 - mx) : 0.f;
        const float l = wave_sum(p0 + p1 + p2);
        LDS_WAIT();
        sp[lane] = p0; sp[lane + 64] = p1; if (lane == 0) sp[128] = p2;
        LDS_WAIT();
        f32x4 acc = (f32x4){0.f, 0.f, 0.f, 0.f};
#pragma unroll 1
        for (int bt = 0; bt < 3; ++bt) {
            f32x4 vv[11];
#pragma unroll
            for (int i = 0; i < 11; ++i) { const int j = 4 * (bt * 11 + i) + ksub; vv[i] = (f32x4){0.f, 0.f, 0.f, 0.f};
                if (j <= 128) { const int idx = lb + t - d * j;
                    if (idx >= lb) { const u32x2 w = *(const u32x2*)(vnew + (size_t)(idx - lb) * NQKV); vv[i] = (f32x4){bf_lo(w.x), bf_hi(w.x), bf_lo(w.y), bf_hi(w.y)}; }
                    else vv[i] = *(const f32x4*)(cache + (size_t)idx * 1024 + 512); } }
#pragma unroll
            for (int i = 0; i < 11; ++i) { const int j = 4 * (bt * 11 + i) + ksub; const float pj = j <= 128 ? sp[j] : 0.f; acc += vv[i] * pj; }
        }
#pragma unroll
        for (int c = 0; c < 4; ++c) { float a = acc[c]; a += __shfl_xor(a, 16); a += __shfl_xor(a, 32); acc[c] = a; }
        const float invl = fast_rcp(l);
        if (ksub == 0) { u32x2 w; w.x = cvt_pk_bf16(acc[0] * invl, acc[1] * invl); w.y = cvt_pk_bf16(acc[2] * invl, acc[3] * invl);
            *(u32x2*)(og + ((size_t)g * MPAD + row) * 512 + h * 64 + 4 * d4) = w; }
        if (lane == 0) AG_ST(lse + (size_t)row * 24 + g * 8 + h, mx + __builtin_amdgcn_logf(l));
    }
}

__device__ __forceinline__ void merge_conv(const Params& P, int layer) {
    const int tid = fresh_tid(), lane = tid & 63, gw = blockIdx.x * 8 + (tid >> 6), ngw = gridDim.x * 8;
    const bf16_t* og = (const bf16_t*)(P.ws + WS_OG); const float* lse = (const float*)(P.ws + WS_LSE);
    bf16_t* a = (bf16_t*)(P.ws + WS_A); bf16_t* c = (bf16_t*)(P.ws + WS_C);
    const bf16_t* cb = (const bf16_t*)(P.ws + WS_CB); const bf16_t* zc = (const bf16_t*)(P.ws + WS_ZC);
    const float* cw = P.in[12] + (size_t)layer * 3 * 1024; const float* st = P.in[5];
    for (int row = gw; row < MV; row += ngw) {
        {
            const int head = lane >> 3; const float* lp = lse + (size_t)row * 24 + head;
            const float l0 = AG_LD(lp), l1 = AG_LD(lp + 8), l2 = AG_LD(lp + 16), mx = fmaxf(l0, fmaxf(l1, l2));
            float w0 = fast_exp2(l0 - mx), w1 = fast_exp2(l1 - mx), w2 = fast_exp2(l2 - mx); const float inv = fast_rcp(w0 + w1 + w2); w0 *= inv; w1 *= inv; w2 *= inv;
            f32x4 x0, x1, y0, y1, z0, z1;
            unpack8(*(const u32x4*)(og + ((size_t)0 * MPAD + row) * 512 + 8 * lane), x0, x1);
            unpack8(*(const u32x4*)(og + ((size_t)1 * MPAD + row) * 512 + 8 * lane), y0, y1);
            unpack8(*(const u32x4*)(og + ((size_t)2 * MPAD + row) * 512 + 8 * lane), z0, z1);
            *(u32x4*)(a + (size_t)row * 512 + 8 * lane) = pack8(x0 * w0 + y0 * w1 + z0 * w2, x1 * w0 + y1 * w1 + z1 * w2);
        }
#pragma unroll
        for (int hf = 0; hf < 2; ++hf) {
            const int ch = 16 * lane + 8 * hf;
            f32x4 b0, b1, t0a, t0b, t1a, t1b, t2a, t2b;
            unpack8(*(const u32x4*)(cb + (size_t)row * DM + ch), b0, b1);
            unpack8(*(const u32x4*)(zc + (size_t)row * DM + ch), t0a, t0b);
            bool has1, has2; const float* s1 = nullptr; const float* s2 = nullptr;
            if (row < MP) { const int pos = row & 8191; has1 = pos >= 1; has2 = pos >= 2; }
            else { const int sr = row - MP, bd = sr >> 2, t = sr & 3; has1 = t >= 1; has2 = t >= 2;
                s1 = st + ((size_t)(layer * 32 + bd) * 2 + 1) * 1024 + ch; s2 = st + ((size_t)(layer * 32 + bd) * 2 + t) * 1024 + ch; }
            if (has1) unpack8(*(const u32x4*)(zc + (size_t)(row - 1) * DM + ch), t1a, t1b);
            else if (s1) { t1a = *(const f32x4*)s1; t1b = *(const f32x4*)(s1 + 4); } else { t1a = (f32x4){0.f, 0.f, 0.f, 0.f}; t1b = t1a; }
            if (has2) unpack8(*(const u32x4*)(zc + (size_t)(row - 2) * DM + ch), t2a, t2b);
            else if (s2) { t2a = *(const f32x4*)s2; t2b = *(const f32x4*)(s2 + 4); } else { t2a = (f32x4){0.f, 0.f, 0.f, 0.f}; t2b = t2a; }
            const f32x4 w0a = *(const f32x4*)(cw + ch), w0b = *(const f32x4*)(cw + ch + 4), w1a = *(const f32x4*)(cw + 1024 + ch), w1b = *(const f32x4*)(cw + 1024 + ch + 4),
                        w2a = *(const f32x4*)(cw + 2048 + ch), w2b = *(const f32x4*)(cw + 2048 + ch + 4);
            *(u32x4*)(c + (size_t)row * DM + ch) = pack8(b0 * (w0a * t2a + w1a * t1a + w2a * t0a), b1 * (w0b * t2b + w1b * t1b + w2b * t0b));
        }
    }
}

__device__ __forceinline__ void final_norm(const Params& P) {
    const int tid = fresh_tid(), lane = tid & 63, gw = blockIdx.x * 8 + (tid >> 6), ngw = gridDim.x * 8;
    const float* xres = (const float*)(P.ws + WS_XRES); const f32x4* gn = (const f32x4*)P.in[19] + lane;
    for (int row = gw; row < MV; row += ngw) {
        const f32x4* xr = (const f32x4*)(xres + (size_t)row * DM) + lane; f32x4 v[4]; float s = 0.f;
#pragma unroll
        for (int j = 0; j < 4; ++j) { v[j] = xr[64 * j]; s += (v[j][0] * v[j][0] + v[j][1] * v[j][1]) + (v[j][2] * v[j][2] + v[j][3] * v[j][3]); }
        const float inv = __builtin_amdgcn_rsqf(wave_sum(s) * (1.0f / 1024.0f) + RMS_EPS);
        f32x4* o = (f32x4*)(P.out + (row < MP ? O_YP + (size_t)row * DM : O_YS + (size_t)(row - MP) * DM)) + lane;
#pragma unroll
        for (int j = 0; j < 4; ++j) o[64 * j] = v[j] * inv * gn[64 * j];
    }
}

#define XB_TMO      128
#define XB_XCNT(j)  (256  + 64 * (j))
#define XB_XSUB(j)  (1280 + 64 * (j))
#define XB_XGEN(j)  (2304 + 64 * (j))
#define XB_TOP      3328
#define XB_TOPGEN   3392
#define XCD_BAR_WORDS 3456
#define XB_SPIN_CAP (1u << 18)

__device__ __forceinline__ unsigned xb_ld(unsigned* p)              { return __hip_atomic_load(p, __ATOMIC_RELAXED, __HIP_MEMORY_SCOPE_AGENT); }
__device__ __forceinline__ unsigned xb_add(unsigned* p, unsigned v) { return __hip_atomic_fetch_add(p, v, __ATOMIC_RELAXED, __HIP_MEMORY_SCOPE_AGENT); }
__device__ __forceinline__ unsigned xb_xcc_id() { return (unsigned)__builtin_amdgcn_s_getreg((3 << 11) | 20) & 0xFu; }
#define XB_SPIN(cond, bar) do { unsigned _sp = 0; while (cond) { __builtin_amdgcn_s_sleep(1); \
    if ((++_sp & 255u) == 0u) { if (xb_ld(&(bar)[XB_TMO])) break; if (_sp > XB_SPIN_CAP) { atomicAdd(&(bar)[XB_TMO], 1u); break; } } } } while (0)

struct XcdBarrier {
    unsigned* bar; unsigned x;
    volatile LAS unsigned* st;
};

__device__ __forceinline__ XcdBarrier xcd_barrier_post(unsigned* bar, volatile LAS unsigned* st) {
    XcdBarrier b; b.bar = bar; b.x = xb_xcc_id(); b.st = st;
    if (threadIdx.x == 0) (void)xb_add(&bar[XB_XCNT(b.x)], 1u);
    return b;
}
__device__ __forceinline__ void xcd_barrier_complete(unsigned* bar, unsigned x, unsigned& nloc, unsigned& nx) {
    const unsigned G = gridDim.x * gridDim.y * gridDim.z;
    unsigned sum, cnt, mine, sp = 0u;
    for (;;) {
        sum = 0u; cnt = 0u; mine = 0u;
#pragma unroll
        for (unsigned j = 0; j < 16; ++j) { const unsigned c = xb_ld(&bar[XB_XCNT(j)]); sum += c; cnt += (c > 0u) ? 1u : 0u; mine = (j == x) ? c : mine; }
        if (sum == G) break;
        __builtin_amdgcn_s_sleep(1);
        if ((++sp & 255u) == 0u) { if (xb_ld(&bar[XB_TMO])) break; if (sp > XB_SPIN_CAP) { atomicAdd(&bar[XB_TMO], 1u); break; } }
    }
    nloc = mine > 0u ? mine : 1u; nx = cnt > 0u ? cnt : 1u;
}

__device__ __forceinline__ void xcd_barrier(const XcdBarrier& b) {
    asm volatile("s_waitcnt vmcnt(0)" ::: "memory");
    __syncthreads();
    if (threadIdx.x == 0) {
        unsigned* bar = b.bar;
        __builtin_amdgcn_s_waitcnt(0);
        unsigned nloc = b.st[0], nx = b.st[1];
        if (nloc == 0u) { xcd_barrier_complete(bar, b.x, nloc, nx); b.st[0] = nloc; b.st[1] = nx; }
        const unsigned old = xb_add(&bar[XB_XSUB(b.x)], 1u);
        const unsigned gen = old / nloc;
        if (old + 1u == (gen + 1u) * nloc) {
            __builtin_amdgcn_fence(__ATOMIC_RELEASE, "agent");
            asm volatile("s_waitcnt vmcnt(0)" ::: "memory");
            const unsigned og = xb_add(&bar[XB_TOP], 1u);
            const unsigned tg = og / nx;
            if (og + 1u == (tg + 1u) * nx) xb_add(&bar[XB_TOPGEN], 1u);
            else XB_SPIN(xb_ld(&bar[XB_TOPGEN]) == tg, bar);
            __builtin_amdgcn_fence(__ATOMIC_ACQUIRE, "agent");
            xb_add(&bar[XB_XGEN(b.x)], 1u);
            asm volatile("s_waitcnt vmcnt(0)" ::: "memory");
        } else {
            XB_SPIN(xb_ld(&bar[XB_XGEN(b.x)]) == gen, bar);
            __builtin_amdgcn_fence(__ATOMIC_ACQUIRE, "agent");
            asm volatile("s_waitcnt vmcnt(0)" ::: "memory");
        }
    }
    __syncthreads();
}

template <int MODE  >
__device__ __forceinline__ void sample_strip(LAS unsigned char* lds, const bf16_t* A, const bf16_t* Bt, int K, unsigned char* ws, float scale) {
    const int bx = fresh_bid();
    if (bx < 4 || bx >= 132) return;
    const int tid = fresh_tid(), lane = tid & 63, wave = tid >> 6, fr = lane & 15, fq = lane >> 4, sid = bx - 4;
    const int r0 = MP + 16 * (sid & 7), c0 = 64 * (sid >> 3), kw = K >> 3, kb = wave * kw;
    const bf16_t* ap = A + (size_t)(r0 + fr) * K + kb + 8 * fq; const bf16_t* bp = Bt + (size_t)(c0 + fr) * K + kb + 8 * fq;
    f32x4 acc[4];
#pragma unroll
    for (int t = 0; t < 4; ++t) acc[t] = (f32x4){0.f, 0.f, 0.f, 0.f};
#pragma unroll 11
    for (int k = 0; k < kw; k += 32) {
        const bf16x8 af = *(const bf16x8*)(ap + k);
#pragma unroll
        for (int t = 0; t < 4; ++t) { const bf16x8 bf = *(const bf16x8*)(bp + (size_t)(16 * t) * K + k); acc[t] = __builtin_amdgcn_mfma_f32_16x16x32_bf16(bf, af, acc[t], 0, 0, 0); }
    }
    LAS f32x4* red = (LAS f32x4*)lds;
#pragma unroll
    for (int t = 0; t < 4; ++t) red[(wave * 4 + t) * 64 + lane] = acc[t];
    __syncthreads();
    if (wave == 0) {
#pragma unroll
        for (int w = 1; w < 8; ++w)
#pragma unroll
            for (int t = 0; t < 4; ++t) acc[t] += red[(w * 4 + t) * 64 + lane];
    }
    __syncthreads();
    if (wave != 0) return;
    const int row = r0 + fr;
    if (MODE == 0) {
        float* xres = (float*)(ws + WS_XRES); bf16_t* xb = (bf16_t*)(ws + WS_XB); float* rss = (float*)(ws + WS_RSS); float ss = 0.f;
#pragma unroll
        for (int t = 0; t < 4; ++t) { const int col = c0 + 16 * t + 4 * fq; float* p = xres + (size_t)row * DM + col; f32x4 r = *(const f32x4*)p; r += acc[t] * scale; *(f32x4*)p = r;
            u32x2 w; w.x = cvt_pk_bf16(r[0], r[1]); w.y = cvt_pk_bf16(r[2], r[3]); *(u32x2*)(xb + (size_t)row * DM + col) = w;
            ss += (r[0] * r[0] + r[1] * r[1]) + (r[2] * r[2] + r[3] * r[3]); }
        ss += __shfl_xor(ss, 16); ss += __shfl_xor(ss, 32);
        if (fq == 0) AG_ST(rss + ((size_t)(c0 >> 8) * MPAD + row) * 4 + ((c0 >> 6) & 3), ss);
    } else {
        const bf16_t* gates = (const bf16_t*)(ws + WS_GATES); float* mtmp = (float*)(ws + WS_MTMP); bf16_t* mo = (bf16_t*)(ws + WS_M);
#pragma unroll
        for (int t = 0; t < 4; ++t) { const int col = c0 + 16 * t + 4 * fq; const u32x2 gw = *(const u32x2*)(gates + (size_t)row * 2048 + (MODE == 2 ? 1024 : 0) + col);
            const f32x4 g = (f32x4){bf_lo(gw.x), bf_hi(gw.x), bf_lo(gw.y), bf_hi(gw.y)}; float* p = mtmp + (size_t)row * DM + col;
            if (MODE == 1) *(f32x4*)p = acc[t] * g;
            else { const f32x4 r = *(const f32x4*)p + acc[t] * g; u32x2 w; w.x = cvt_pk_bf16(r[0], r[1]); w.y = cvt_pk_bf16(r[2], r[3]); *(u32x2*)(mo + (size_t)row * DM + col) = w; } }
    }
}

#ifndef N_LAUNCHES
#define N_LAUNCHES 1
#endif
constexpr int N_PHASES = 20;
__global__ void __launch_bounds__(512, 2) fwd_megakernel(Params P) {
    extern __shared__ __attribute__((aligned(16))) unsigned char lds_raw[];
    LAS unsigned char* lds = (LAS unsigned char*)lds_raw;
    cg::grid_group grid = cg::this_grid();
    volatile LAS unsigned* xst = (volatile LAS unsigned*)(lds + 133120);
    if (threadIdx.x < 2) xst[threadIdx.x] = 0u;
    __syncthreads();
    XcdBarrier xbar; xbar.bar = (unsigned*)(P.ws + WS_CTL); xbar.x = 0; xbar.st = xst;
    if (P.ph_hi - P.ph_lo > 1) xbar = xcd_barrier_post((unsigned*)(P.ws + WS_CTL), xst);
    if (P.ws == nullptr) grid.sync();
    const int G = gridDim.x;
    const int lo = P.ph_lo, hi = P.ph_hi;
    int ph = 0;
#define WSF() ({ size_t z_ = 0; asm volatile("" : "+s"(z_)); P.ws + z_; })
#define RUN (ph >= lo && ph < hi)
#define SEAM() do { if (ph >= lo && ph + 1 < hi) xcd_barrier(xbar); ++ph; } while (0)

    if (RUN) {
        const int tid = fresh_tid(), lane = tid & 63, wave = tid >> 6, gw = blockIdx.x * 8 + wave, ngw = G * 8;
        conv_weights(P, (LAS float*)(lds + wave * 16384), gw, ngw, lane);
        init_x(P, gw, ngw, lane);
    }
    SEAM();
#pragma unroll 1
    for (int l = 0; l < NLAYER; ++l) {
#pragma unroll 1
        for (int f = 0; f < 2; ++f) {
            if (RUN) {
                unsigned char* ws = WSF(); unsigned char* wl = ws + WS_W + (size_t)l * LW_END;
                if (G > FFN_UP_GRID && (int)blockIdx.x >= FFN_UP_GRID) { constexpr size_t R0 = CP_ATT_N / 256, RN = CP_DED_N / 256; copy_dedicated(P, R0 + RN * (size_t)(2 * l + f) / 4, R0 + RN * (size_t)(2 * l + f + 1) / 4, FFN_UP_GRID); }
                else {
                pg8::Gemm g{(const bf16_t*)(ws + WS_XB), (const bf16_t*)(wl + (f ? LW_W2I : LW_W1I)), MPAD, 2 * DFF, DM}; pg8::StaticOrder S; S.init(MPAD, 2 * DFF, G > FFN_UP_GRID ? FFN_UP_GRID : G, (int)blockIdx.x);
                EpiSwiGLU E{(bf16_t*)(ws + WS_ACT), (const float*)(ws + WS_RSS)};
                pg8::gemm_phase<EpiSwiGLU, pg8::StaticOrder, true, true>(lds, g, S, E);
                }
            }
            SEAM();
            if (RUN) {
                unsigned char* ws = WSF(); unsigned char* wl = ws + WS_W + (size_t)l * LW_END;
                pg8::Gemm g{(const bf16_t*)(ws + WS_ACT), (const bf16_t*)(wl + (f ? LW_W2O : LW_W1O)), MP, DM, DFF}; pg8::StaticOrder S; S.init(MP, DM, G, (int)blockIdx.x);
                EpiResid E{(float*)(ws + WS_XRES), (bf16_t*)(ws + WS_XB), (float*)(ws + WS_RSS), 0.5f};
                pg8::gemm_phase<EpiResid, pg8::StaticOrder, true, true>(lds, g, S, E);
                sample_strip<0>(lds, (const bf16_t*)(ws + WS_ACT), (const bf16_t*)(wl + (f ? LW_W2O : LW_W1O)), DFF, ws, 0.5f);
                if (G > 132 && (int)blockIdx.x >= 132) { constexpr size_t R0 = (CP_ATT_N + CP_DED_N + CP_DED2_N) / 256, RN = CP_DED3_N / 256;
                    copy_dedicated(P, R0 + RN * (size_t)(2 * l + f) / 4, R0 + RN * (size_t)(2 * l + f + 1) / 4, 132); }
            }
            SEAM();
            if (f == 0) {
                if (RUN) {
                    unsigned char* ws = WSF(); unsigned char* wl = ws + WS_W + (size_t)l * LW_END;
                    if (G > PROJ_GRID && (int)blockIdx.x >= PROJ_GRID) { constexpr size_t R0 = (CP_ATT_N + CP_DED_N) / 256, RN = CP_DED2_N / 256; copy_dedicated(P, R0 + RN * (size_t)l / 2, R0 + RN * (size_t)(l + 1) / 2, PROJ_GRID); }
                    else {
                    pg8::Gemm g{(const bf16_t*)(ws + WS_XB), (const bf16_t*)(wl + LW_WIN), MPAD, NIN, DM}; pg8::StaticOrder S; S.init(MPAD, NIN, G > PROJ_GRID ? PROJ_GRID : G, (int)blockIdx.x);
                    EpiProj E{ws, P.in[11] + (size_t)l * 2048, P.out, l};
                    pg8::gemm_phase<EpiProj, pg8::StaticOrder, true, true>(lds, g, S, E);
                    }
                }
                SEAM();
                if (RUN) {
                    unsigned char* ws = WSF();
                    attn_prompt(lds, P, l, (const bf16_t*)(ws + WS_Q), (const bf16_t*)(ws + WS_K), (const bf16_t*)(ws + WS_V), (bf16_t*)(ws + WS_OG), (float*)(ws + WS_LSE));
                    attn_sample(lds, P, l, (const bf16_t*)(ws + WS_Q), (const bf16_t*)(ws + WS_K), (const bf16_t*)(ws + WS_V), (bf16_t*)(ws + WS_OG), (float*)(ws + WS_LSE));
                }
                SEAM();
                if (RUN) merge_conv(P, l);
                SEAM();
                if (RUN) {
                    {
                        unsigned char* ws = WSF(); unsigned char* wl = ws + WS_W + (size_t)l * LW_END;
                        pg8::StaticOrder S; S.init(MPAD, DM, G, (int)blockIdx.x);
                        pg8::Gemm g1{(const bf16_t*)(ws + WS_A), (const bf16_t*)(wl + LW_WAO), MPAD, DM, 512}; EpiMixA E1{(const bf16_t*)(ws + WS_GATES), (float*)(ws + WS_MTMP)};
                        pg8::gemm_phase<EpiMixA, pg8::StaticOrder, true, true>(lds, g1, S, E1);
                    }
                    {
                        unsigned char* ws = WSF(); unsigned char* wl = ws + WS_W + (size_t)l * LW_END;
                        pg8::StaticOrder S; S.init(MPAD, DM, G, (int)blockIdx.x);
                        pg8::Gemm g2{(const bf16_t*)(ws + WS_C), (const bf16_t*)(wl + LW_WCO), MPAD, DM, DM}; EpiMixB E2{(const bf16_t*)(ws + WS_GATES), (const float*)(ws + WS_MTMP), (bf16_t*)(ws + WS_M)};
                        pg8::gemm_phase<EpiMixB, pg8::StaticOrder, true, true>(lds, g2, S, E2);
                        copy_part(P, 10 * l, 6);
                    }
                }
                SEAM();
                if (RUN) {
                    unsigned char* ws = WSF(); unsigned char* wl = ws + WS_W + (size_t)l * LW_END;
                    pg8::Gemm g{(const bf16_t*)(ws + WS_M), (const bf16_t*)(wl + LW_WO), MPAD, DM, DM}; pg8::StaticOrder S; S.init(MPAD, DM, G, (int)blockIdx.x);
                    EpiResid E{(float*)(ws + WS_XRES), (bf16_t*)(ws + WS_XB), (float*)(ws + WS_RSS), 1.0f};
                    pg8::gemm_phase<EpiResid, pg8::StaticOrder, true, true>(lds, g, S, E);
                    copy_part(P, 10 * l + 6, 4);
                }
                SEAM();
            }
        }
    }
    if (RUN) {
#ifdef DUMPG
      const int tid2 = fresh_tid(); const bf16_t* gsrc = (const bf16_t*)(P.ws + WS_GATES);
      for (size_t i = (size_t)blockIdx.x * 512 + tid2; i < (size_t)MV * DM; i += (size_t)gridDim.x * 512) { const size_t row = i >> 10, col = i & 1023; P.out[i] = bf2f(gsrc[row * 2048 + col]) + 2.f * bf2f(gsrc[row * 2048 + 1024 + col]); }
#else
      final_norm(P);
#endif
    }
}

extern "C" void kernel_launch(void* const* d_in, const int* in_sizes, int n_in, void* d_out, int out_size, void* d_ws, size_t ws_size, hipStream_t stream) {
    static int grid = 0;
    if (grid == 0) {
        if (n_in != 20 || ws_size < WS_END) { fprintf(stderr, "kernel_launch: unexpected n_in %d / ws %zu (need %zu)\n", n_in, ws_size, (size_t)WS_END); grid = -1; return; }
        int dev = 0, cus = 0;
        (void)hipGetDevice(&dev); (void)hipDeviceGetAttribute(&cus, hipDeviceAttributeMultiprocessorCount, dev);
        (void)hipFuncSetAttribute((const void*)fwd_megakernel, hipFuncAttributeMaxDynamicSharedMemorySize, LDS_BYTES);
        grid = cus;
        (void)hipGetLastError();
    }
    if (grid < 0) return;
    (void)hipMemsetAsync((char*)d_ws + WS_CTL, 0, CTL_BYTES, stream);
    Params p{};
    for (int i = 0; i < 20; ++i) p.in[i] = (const float*)d_in[i];
    p.out = (float*)d_out; p.ws = (unsigned char*)d_ws;
    for (int li = 0; li < N_LAUNCHES; ++li) {
        p.ph_lo = (N_LAUNCHES == 1) ? 0 : li; p.ph_hi = (N_LAUNCHES == 1) ? N_PHASES : li + 1;
        void* args[] = {&p};
        hipError_t e = hipLaunchCooperativeKernel((const void*)fwd_megakernel, dim3(grid), dim3(512), args, LDS_BYTES, stream);
        if (e != hipSuccess) { fprintf(stderr, "cooperative launch failed: %s (grid %d)\n", hipGetErrorString(e), grid); break; }
    }
}
```

```cpp
#include <hip/hip_runtime.h>
#include <hip/hip_cooperative_groups.h>
#include <cstdio>
#include <cstdint>
namespace cg = cooperative_groups;

#define LAS __attribute__((address_space(3)))
#define EXP_SIG(x) sigmoidf_(x)
#define ABL_A 1.f
#define ABL_C 1.f
typedef unsigned short bf16_t;
typedef short bf16x8 __attribute__((ext_vector_type(8)));
typedef float f32x4 __attribute__((ext_vector_type(4)));
typedef unsigned u32x4 __attribute__((ext_vector_type(4)));
typedef unsigned u32x2 __attribute__((ext_vector_type(2)));

constexpr int DM = 1024, SEQ = 8192, NB = 2, MP = NB * SEQ  , MS = 128, MV = MP + MS  , MPAD = 16640;
constexpr int DFF = 2816, NQKV = 1536, NIN = 9728, NLAYER = 2;
constexpr float RMS_EPS = 1e-6f;
constexpr float QSCALE = 0.125f * 1.4426950408889634f;

constexpr size_t O_YP = 0, O_YS = 16777216, O_KVP0 = 16908288, O_KVP1 = 17432576, O_KVP2 = 19529728, O_CONVP = 27918336,
                 O_KVS0 = 27926528, O_KVS1 = 36315136, O_KVS2 = 69869568, O_CONVS = 204087296;

constexpr size_t al(size_t x) { return (x + 0xFFFFF) & ~(size_t)0xFFFFF; }
constexpr size_t SZ_W1I = (size_t)2 * DFF * DM * 2, SZ_W1O = (size_t)DM * DFF * 2, SZ_WIN = (size_t)NIN * DM * 2, SZ_WAO = (size_t)DM * 512 * 2,
                 SZ_WCO = (size_t)DM * DM * 2, SZ_WO = (size_t)DM * DM * 2;
constexpr size_t LW_W1I = 0, LW_W1O = LW_W1I + SZ_W1I, LW_WIN = LW_W1O + SZ_W1O, LW_WAO = LW_WIN + SZ_WIN, LW_WCO = LW_WAO + SZ_WAO, LW_WO = LW_WCO + SZ_WCO,
                 LW_W2I = LW_WO + SZ_WO, LW_W2O = LW_W2I + SZ_W1I, LW_END = LW_W2O + SZ_W1O;
constexpr size_t WS_W = 0;
constexpr size_t WS_XRES = al(WS_W + 2 * LW_END);
constexpr size_t WS_XB = al(WS_XRES + (size_t)MPAD * DM * 4);
constexpr size_t WS_RSS = al(WS_XB + (size_t)MPAD * DM * 2);
constexpr size_t WS_ACT = al(WS_RSS + (size_t)MPAD * 16 * 4);
constexpr size_t WS_Q = al(WS_ACT + (size_t)MPAD * DFF * 2);
constexpr size_t WS_K = al(WS_Q + (size_t)MPAD * NQKV * 2);
constexpr size_t WS_V = al(WS_K + (size_t)MPAD * NQKV * 2);
constexpr size_t WS_CB = al(WS_V + (size_t)MPAD * NQKV * 2);
constexpr size_t WS_ZC = al(WS_CB + (size_t)MPAD * DM * 2);
constexpr size_t WS_GATES = al(WS_ZC + (size_t)MPAD * DM * 2);
constexpr size_t WS_OG = al(WS_GATES + (size_t)MPAD * 2048 * 2);
constexpr size_t WS_LSE = al(WS_OG + (size_t)3 * MPAD * 512 * 2);
constexpr size_t WS_A = al(WS_LSE + (size_t)MPAD * 24 * 4);
constexpr size_t WS_C = al(WS_A + (size_t)MPAD * 512 * 2);
constexpr size_t WS_MTMP = al(WS_C + (size_t)MPAD * DM * 2);
constexpr size_t WS_M = al(WS_MTMP + (size_t)MPAD * DM * 4);
constexpr size_t WS_CTL = al(WS_M + (size_t)MPAD * DM * 2);
constexpr size_t CTL_BYTES = 65536;
constexpr size_t WS_END = al(WS_CTL + CTL_BYTES);
static_assert(WS_V - WS_K == WS_K - WS_Q, "q/k/v equally spaced");

constexpr int LDS_BYTES = 135168;

typedef float f32x2_t __attribute__((ext_vector_type(2)));
typedef __bf16 bf16x2_t __attribute__((ext_vector_type(2)));
__device__ __forceinline__ unsigned cvt_pk_bf16(float lo, float hi) { const f32x2_t v = {lo, hi}; const bf16x2_t b = __builtin_convertvector(v, bf16x2_t); return __builtin_bit_cast(unsigned, b); }
__device__ __forceinline__ float bf_lo(unsigned w) { return __uint_as_float(w << 16); }
__device__ __forceinline__ float bf_hi(unsigned w) { return __uint_as_float(w & 0xffff0000u); }
__device__ __forceinline__ float bf2f(bf16_t h) { return __uint_as_float((unsigned)h << 16); }
__device__ __forceinline__ u32x4 pack8(f32x4 a, f32x4 b) { u32x4 w; w.x = cvt_pk_bf16(a[0], a[1]); w.y = cvt_pk_bf16(a[2], a[3]); w.z = cvt_pk_bf16(b[0], b[1]); w.w = cvt_pk_bf16(b[2], b[3]); return w; }
__device__ __forceinline__ void unpack8(u32x4 w, f32x4& a, f32x4& b) { a = (f32x4){bf_lo(w.x), bf_hi(w.x), bf_lo(w.y), bf_hi(w.y)}; b = (f32x4){bf_lo(w.z), bf_hi(w.z), bf_lo(w.w), bf_hi(w.w)}; }
__device__ __forceinline__ float fast_rcp(float x) { return __builtin_amdgcn_rcpf(x); }
__device__ __forceinline__ float fast_exp2(float x) { return __builtin_amdgcn_exp2f(x); }
__device__ __forceinline__ float sigmoidf_(float x) { return fast_rcp(1.f + fast_exp2(-1.4426950408889634f * x)); }
__device__ __forceinline__ float wave_sum(float v) {
#pragma unroll
    for (int o = 1; o < 64; o <<= 1) v += __shfl_xor(v, o);
    return v;
}
__device__ __forceinline__ float wave_max(float v) {
#pragma unroll
    for (int o = 1; o < 64; o <<= 1) v = fmaxf(v, __shfl_xor(v, o));
    return v;
}
#define LDS_WAIT() asm volatile("s_waitcnt lgkmcnt(0)" ::: "memory")
__device__ __forceinline__ int fresh_bid() { int b = blockIdx.x; asm volatile("" : "+s"(b)); return b; }
__device__ __forceinline__ int fresh_tid() { int t = threadIdx.x; asm volatile("" : "+v"(t)); return t; }

namespace pg8 {
constexpr int BM = 256, BK = 64, HALF = 128, HTB = HALF * BK * 2, STAGE_BYTES = 8 * HTB, NXCD = 8, WGM = 8;
__host__ __device__ __forceinline__ int lds_byte(int r, int c) { const int st = (r >> 4) * 2 + (c >> 5), rr = r & 15, cc = c & 31, ob = rr * 64 + cc * 2; return st * 1024 + (ob ^ (((ob >> 9) & 1) << 5)); }
__host__ __device__ __forceinline__ void stage_rc(int b, int& R, int& C) { const int st = b / 1024, sb = b % 1024, swz = sb ^ (((sb >> 9) & 1) << 5); R = (st >> 1) * 16 + swz / 64; C = (st & 1) * 32 + (swz % 64) / 2; }
__host__ __device__ __forceinline__ int perm32(int rho) { const int n = rho >> 4, i = rho & 15; return 8 * (i >> 2) + 4 * n + (i & 3); }

struct Unit { int pm, pn; };
struct Gemm { const bf16_t* A; const bf16_t* Bt; int M, N, K; };

struct StaticOrder {
    int nM, nN, nwg, G, c;
    __device__ void init(int M, int N, int G_, int c_) { nM = M / BM; nN = N / BM; nwg = nM * nN; G = G_; c = c_; }
    __device__ bool next(int i, Unit& u) const {
        const long L = (long)i * G + c; if (L >= nwg) return false;
        int wgid = (int)L; { const int q = nwg / NXCD, r = nwg % NXCD, xcd = wgid % NXCD, off = wgid / NXCD; wgid = (xcd < r ? xcd * (q + 1) : r * (q + 1) + (xcd - r) * q) + off; }
        const int nig = WGM * nN, gid = wgid / nig, fm = gid * WGM, gsz = (nM - fm) < WGM ? (nM - fm) : WGM;
        u.pm = fm + ((wgid % nig) % gsz); u.pn = (wgid % nig) / gsz; return true;
    }
    __device__ __forceinline__ void a_ready(const Unit&) const {}
    __device__ __forceinline__ void done(const Unit&) const {}
};

template <class Epi, class Sched, bool ALIGN_EPI = false, bool SP2 = false>
__device__ __forceinline__ void gemm_phase(LAS unsigned char* lds, const Gemm g, const Sched& S, const Epi& E) {
    const int tid = fresh_tid(), wid = __builtin_amdgcn_readfirstlane(tid >> 6), lane = tid & 63, wr = wid >> 2, wc = wid & 3, fr = lane & 15, fq = lane >> 4;
    const int K = g.K, nt = K / BK;
    unsigned voffA[2], voffB[2];
#pragma unroll
    for (int i = 0; i < 2; ++i) { int R, C; stage_rc(tid * 16 + i * 8192, R, C); const int Rb = Epi::PERM ? ((R & ~31) + perm32(R & 31)) : R;
        voffA[i] = (unsigned)(R * K + C) * 2u; voffB[i] = (unsigned)(Rb * K + C) * 2u; }
    const size_t kstep = (size_t)(BK * 2);
    const size_t hstep = (size_t)HALF * K * 2;
    const size_t tstep = 2 * hstep;
    const unsigned ldsw = (unsigned)wid * 1024u;
    const int aoff = lds_byte(wr * 64 + fr, fq * 8), boff = lds_byte(wc * 32 + fr, fq * 8);
#define PG8_SA(b, h) (((b) * 2 + (h)) * HTB)
#define PG8_SB(b, h) ((4 + (b) * 2 + (h)) * HTB)
#define PG8_STAGE(bufoff, gbase, voff) do { _Pragma("unroll") for (int _i = 0; _i < 2; ++_i) \
        __builtin_amdgcn_global_load_lds((const unsigned*)((const char*)(gbase) + (voff)[_i]), (LAS unsigned*)(lds + (bufoff) + ldsw + _i * 8192), 16, 0, 0); } while (0)
#define PG8_LDA(dst, b, h) do { _Pragma("unroll") for (int m = 0; m < 4; ++m) _Pragma("unroll") for (int k = 0; k < 2; ++k) dst[m][k] = *(const LAS bf16x8*)(lds + PG8_SA(b, h) + aoff + m * 2048 + k * 1024); } while (0)
#define PG8_LDB(dst, b, h) do { _Pragma("unroll") for (int n = 0; n < 2; ++n) _Pragma("unroll") for (int k = 0; k < 2; ++k) dst[n][k] = *(const LAS bf16x8*)(lds + PG8_SB(b, h) + boff + n * 2048 + k * 1024); } while (0)
#define PG8_MMA(ai, bj, At, Bt) do { __builtin_amdgcn_s_setprio(1); _Pragma("unroll") for (int m = 0; m < 4; ++m) _Pragma("unroll") for (int n = 0; n < 2; ++n) _Pragma("unroll") for (int k = 0; k < 2; ++k) \
        acc[ai][bj][m][n] = __builtin_amdgcn_mfma_f32_16x16x32_bf16(Bt[n][k], At[m][k], acc[ai][bj][m][n], 0, 0, 0); __builtin_amdgcn_s_setprio(0); } while (0)
#define PG8_WAIT_V(n) asm volatile("s_waitcnt vmcnt(" #n ")" ::: "memory")
#define PG8_WAIT_L(n) asm volatile("s_waitcnt lgkmcnt(" #n ")" ::: "memory")
#define PG8_BAR __builtin_amdgcn_s_barrier()
#define PG8_SCHED __builtin_amdgcn_sched_barrier(0)
    Unit cur, nxt; int ui = 0;
    if (!S.next(0, cur)) return;
    f32x4 acc[2][2][4][2];
#pragma unroll
    for (int a = 0; a < 2; ++a)
#pragma unroll
        for (int b = 0; b < 2; ++b)
#pragma unroll
            for (int m = 0; m < 4; ++m)
#pragma unroll
                for (int n = 0; n < 2; ++n) acc[a][b][m][n] = (f32x4){0.f, 0.f, 0.f, 0.f};
    bf16x8 At[4][2], B0[2][2], B1[2][2];
    const char* cA = (const char*)g.A + (size_t)cur.pm * tstep; const char* cB = (const char*)g.Bt + (size_t)cur.pn * tstep;
    S.a_ready(cur);
    if constexpr (SP2) {
        PG8_STAGE(PG8_SB(0, 0), cB, voffB); PG8_STAGE(PG8_SB(0, 1), cB + hstep, voffB); PG8_STAGE(PG8_SA(0, 0), cA, voffA); PG8_STAGE(PG8_SA(0, 1), cA + hstep, voffA);
        if (wr == 1) PG8_BAR;
        PG8_WAIT_V(2); PG8_BAR;
        PG8_STAGE(PG8_SB(1, 0), cB + kstep, voffB); PG8_STAGE(PG8_SA(1, 0), cA + kstep, voffA); PG8_STAGE(PG8_SB(1, 1), cB + hstep + kstep, voffB);
        PG8_WAIT_V(6); PG8_BAR;
    } else {
        PG8_STAGE(PG8_SB(0, 0), cB, voffB); PG8_STAGE(PG8_SA(0, 0), cA, voffA); PG8_STAGE(PG8_SB(0, 1), cB + hstep, voffB); PG8_STAGE(PG8_SA(0, 1), cA + hstep, voffA);
        if (wr == 1) PG8_BAR;
        PG8_WAIT_V(4); PG8_BAR;
        PG8_STAGE(PG8_SB(1, 0), cB + kstep, voffB); PG8_STAGE(PG8_SA(1, 0), cA + kstep, voffA); PG8_STAGE(PG8_SB(1, 1), cB + hstep + kstep, voffB);
        PG8_WAIT_V(6); PG8_BAR;
    }
    for (;;) {
        const bool has_next = S.next(ui + 1, nxt);
        const char* nA = has_next ? (const char*)g.A + (size_t)nxt.pm * tstep : cA; const char* nB = has_next ? (const char*)g.Bt + (size_t)nxt.pn * tstep : cB;
        for (int t = 0; t < nt; t += 2) {
            const bool last = (t == nt - 2);
            const char* a1 = cA + (size_t)(t + 1) * kstep;
            const char* a2 = last ? nA : cA + (size_t)(t + 2) * kstep; const char* b2 = last ? nB : cB + (size_t)(t + 2) * kstep;
            const char* a3 = a2 + kstep; const char* b3 = b2 + kstep;
            if (last && has_next) S.a_ready(nxt);
            if constexpr (SP2) {
            PG8_LDB(B0, 0, 0); PG8_LDB(B1, 0, 1); PG8_SCHED; PG8_LDA(At, 0, 0); PG8_STAGE(PG8_SA(1, 1), a1 + hstep, voffA);
            PG8_WAIT_V(8); PG8_WAIT_L(0); PG8_BAR; PG8_MMA(0, 0, At, B0); PG8_MMA(0, 1, At, B1); PG8_BAR; PG8_SCHED;
            PG8_LDA(At, 0, 1); PG8_STAGE(PG8_SB(0, 0), b2, voffB); PG8_STAGE(PG8_SB(0, 1), b2 + hstep, voffB); PG8_STAGE(PG8_SA(0, 0), a2, voffA);
            PG8_WAIT_V(8); PG8_WAIT_L(0); PG8_BAR; PG8_MMA(1, 0, At, B0); PG8_MMA(1, 1, At, B1); PG8_BAR; PG8_SCHED;
            PG8_LDB(B0, 1, 0); PG8_LDB(B1, 1, 1); PG8_SCHED; PG8_LDA(At, 1, 0); PG8_STAGE(PG8_SA(0, 1), a2 + hstep, voffA);
            PG8_WAIT_V(8); PG8_WAIT_L(0); PG8_BAR; PG8_MMA(0, 0, At, B0); PG8_MMA(0, 1, At, B1); PG8_BAR; PG8_SCHED;
            PG8_LDA(At, 1, 1); PG8_STAGE(PG8_SB(1, 0), b3, voffB); PG8_STAGE(PG8_SB(1, 1), b3 + hstep, voffB); PG8_STAGE(PG8_SA(1, 0), a3, voffA);
            PG8_WAIT_V(8); PG8_WAIT_L(0); PG8_BAR; PG8_MMA(1, 0, At, B0); PG8_MMA(1, 1, At, B1); PG8_BAR; PG8_SCHED;
            } else {
            PG8_LDB(B0, 0, 0); PG8_SCHED; PG8_LDA(At, 0, 0); PG8_STAGE(PG8_SA(1, 1), a1 + hstep, voffA);
            PG8_WAIT_L(8); PG8_BAR; PG8_WAIT_L(0); PG8_MMA(0, 0, At, B0); PG8_BAR; PG8_SCHED;
            PG8_LDB(B1, 0, 1); PG8_STAGE(PG8_SB(0, 0), b2, voffB);
            PG8_BAR; PG8_WAIT_L(0); PG8_MMA(0, 1, At, B1); PG8_BAR;
            PG8_LDA(At, 0, 1); PG8_STAGE(PG8_SA(0, 0), a2, voffA);
            PG8_BAR; PG8_WAIT_L(0); PG8_MMA(1, 0, At, B0); PG8_BAR; PG8_SCHED;
            PG8_STAGE(PG8_SB(0, 1), b2 + hstep, voffB);
            PG8_WAIT_V(6); PG8_BAR; PG8_MMA(1, 1, At, B1); PG8_BAR;
            PG8_LDB(B0, 1, 0); PG8_SCHED; PG8_LDA(At, 1, 0); PG8_STAGE(PG8_SA(0, 1), a2 + hstep, voffA);
            PG8_WAIT_L(8); PG8_BAR; PG8_WAIT_L(0); PG8_MMA(0, 0, At, B0); PG8_BAR; PG8_SCHED;
            PG8_LDB(B1, 1, 1); PG8_STAGE(PG8_SB(1, 0), b3, voffB);
            PG8_BAR; PG8_WAIT_L(0); PG8_MMA(0, 1, At, B1); PG8_BAR;
            PG8_LDA(At, 1, 1); PG8_STAGE(PG8_SA(1, 0), a3, voffA);
            PG8_BAR; PG8_WAIT_L(0); PG8_MMA(1, 0, At, B0); PG8_BAR; PG8_SCHED;
            PG8_STAGE(PG8_SB(1, 1), b3 + hstep, voffB);
            PG8_WAIT_V(6); PG8_BAR; PG8_MMA(1, 1, At, B1); PG8_BAR;
            }
        }
        if constexpr (ALIGN_EPI) { if (wr == 0) PG8_BAR; }
        if constexpr (!Epi::AFTER_DRAIN) { E(acc, cur, wr, wc, fr, fq); S.done(cur); }
        if (!has_next) break;
#pragma unroll
        for (int a = 0; a < 2; ++a)
#pragma unroll
            for (int b = 0; b < 2; ++b)
#pragma unroll
                for (int m = 0; m < 4; ++m)
#pragma unroll
                    for (int n = 0; n < 2; ++n) acc[a][b][m][n] = (f32x4){0.f, 0.f, 0.f, 0.f};
        cur = nxt; cA = nA; cB = nB; ++ui;
        if constexpr (ALIGN_EPI) { if (wr == 1) PG8_BAR; }
    }
    PG8_WAIT_V(0);
    if constexpr (!ALIGN_EPI) { if (wr == 0) PG8_BAR; }
    PG8_BAR;
#undef PG8_SA
#undef PG8_SB
#undef PG8_STAGE
#undef PG8_LDA
#undef PG8_LDB
#undef PG8_MMA
#undef PG8_WAIT_V
#undef PG8_WAIT_L
#undef PG8_BAR
#undef PG8_SCHED
}
}

typedef f32x4 Acc[2][2][4][2];

#define AG_LD(p) __hip_atomic_load((p), __ATOMIC_RELAXED, __HIP_MEMORY_SCOPE_AGENT)
#define AG_ST(p, v) __hip_atomic_store((p), (v), __ATOMIC_RELAXED, __HIP_MEMORY_SCOPE_AGENT)
__device__ __forceinline__ float row_ss4(const float* rss, int row, int fq) {
    const f32x4 v = *(const f32x4*)(rss + ((size_t)fq * MPAD + row) * 4);
    return (v[0] + v[1]) + (v[2] + v[3]);
}
__device__ __forceinline__ void rows_inv(const float* rss, int row0, int fq, float (&inv)[2][4]) {
#pragma unroll
    for (int ai = 0; ai < 2; ++ai)
#pragma unroll
        for (int m = 0; m < 4; ++m) inv[ai][m] = row_ss4(rss, row0 + ai * 128 + m * 16, fq);
#pragma unroll
    for (int ai = 0; ai < 2; ++ai)
#pragma unroll
        for (int m = 0; m < 4; ++m) { float s = inv[ai][m]; s += __shfl_xor(s, 16); s += __shfl_xor(s, 32); inv[ai][m] = __builtin_amdgcn_rsqf(s * (1.0f / 1024.0f) + RMS_EPS); }
}

struct EpiSwiGLU {
    static constexpr bool PERM = true, AFTER_DRAIN = false;
    bf16_t* act; const float* rss;
    __device__ __forceinline__ void operator()(const Acc& acc, const pg8::Unit& u, int wr, int wc, int fr, int fq) const {
        const int row0 = u.pm * 256 + wr * 64 + fr, col = u.pn * 128 + wc * 32 + 8 * fq;
        float invs[2][4]; rows_inv(rss, row0, fq, invs);
#pragma unroll
        for (int ai = 0; ai < 2; ++ai)
#pragma unroll
            for (int m = 0; m < 4; ++m) {
                const int row = row0 + ai * 128 + m * 16; const float inv = invs[ai][m];
                f32x4 o[2];
#pragma unroll
                for (int n = 0; n < 2; ++n) { const f32x4 gt = acc[ai][0][m][n] * inv, up = acc[ai][1][m][n] * inv;
#pragma unroll
                    for (int j = 0; j < 4; ++j) o[n][j] = gt[j] * sigmoidf_(gt[j]) * up[j]; }
                *(u32x4*)(act + (size_t)row * DFF + col) = pack8(o[0], o[1]);
            }
    }
};

struct EpiResid {
    static constexpr bool PERM = true, AFTER_DRAIN = false;
    float* xres; bf16_t* xb; float* rss; float scale;
    __device__ __forceinline__ void operator()(const Acc& acc, const pg8::Unit& u, int wr, int wc, int fr, int fq) const {
        const int row0 = u.pm * 256 + wr * 64 + fr, col0 = u.pn * 256 + wc * 32 + 8 * fq;
#pragma unroll
        for (int ai = 0; ai < 2; ++ai)
#pragma unroll
            for (int m = 0; m < 4; ++m) {
                const int row = row0 + ai * 128 + m * 16; float ss = 0.f;
#pragma unroll
                for (int bj = 0; bj < 2; ++bj) {
                    float* p = xres + (size_t)row * DM + col0 + bj * 128;
                    f32x4 r0 = *(const f32x4*)p, r1 = *(const f32x4*)(p + 4);
                    r0 += acc[ai][bj][m][0] * scale; r1 += acc[ai][bj][m][1] * scale;
                    *(f32x4*)p = r0; *(f32x4*)(p + 4) = r1;
                    *(u32x4*)(xb + (size_t)row * DM + col0 + bj * 128) = pack8(r0, r1);
                    ss += (r0[0] * r0[0] + r0[1] * r0[1]) + (r0[2] * r0[2] + r0[3] * r0[3]) + (r1[0] * r1[0] + r1[1] * r1[1]) + (r1[2] * r1[2] + r1[3] * r1[3]);
                }
                ss += __shfl_xor(ss, 16); ss += __shfl_xor(ss, 32);
                if (fq == 0) rss[((size_t)u.pn * MPAD + row) * 4 + wc] = ss;
                if (m & 1) asm volatile("" ::: "memory");
            }
    }
};

struct EpiMixA {
    static constexpr bool PERM = true, AFTER_DRAIN = false;
    const bf16_t* gates; float* mtmp;
    __device__ __forceinline__ void operator()(const Acc& acc, const pg8::Unit& u, int wr, int wc, int fr, int fq) const {
        const int row0 = u.pm * 256 + wr * 64 + fr, col0 = u.pn * 256 + wc * 32 + 8 * fq;
#pragma unroll
        for (int ai = 0; ai < 2; ++ai)
#pragma unroll
            for (int m = 0; m < 4; ++m) {
                const int row = row0 + ai * 128 + m * 16;
#pragma unroll
                for (int bj = 0; bj < 2; ++bj) {
                    const int col = col0 + bj * 128; f32x4 g0, g1; unpack8(*(const u32x4*)(gates + (size_t)row * 2048 + col), g0, g1);
                    float* p = mtmp + (size_t)row * DM + col;
                    *(f32x4*)p = acc[ai][bj][m][0] * g0 * ABL_A; *(f32x4*)(p + 4) = acc[ai][bj][m][1] * g1 * ABL_A;
                    if (bj == 1) asm volatile("" ::: "memory");
                }
            }
    }
};
struct EpiMixB {
    static constexpr bool PERM = true, AFTER_DRAIN = false;
    const bf16_t* gates; const float* mtmp; bf16_t* mo;
    __device__ __forceinline__ void operator()(const Acc& acc, const pg8::Unit& u, int wr, int wc, int fr, int fq) const {
        const int row0 = u.pm * 256 + wr * 64 + fr, col0 = u.pn * 256 + wc * 32 + 8 * fq;
#pragma unroll
        for (int ai = 0; ai < 2; ++ai)
#pragma unroll
            for (int m = 0; m < 4; ++m) {
                const int row = row0 + ai * 128 + m * 16;
#pragma unroll
                for (int bj = 0; bj < 2; ++bj) {
                    const int col = col0 + bj * 128; f32x4 g0, g1; unpack8(*(const u32x4*)(gates + (size_t)row * 2048 + 1024 + col), g0, g1);
                    const float* p = mtmp + (size_t)row * DM + col;
                    const f32x4 r0 = *(const f32x4*)p + acc[ai][bj][m][0] * g0 * ABL_C, r1 = *(const f32x4*)(p + 4) + acc[ai][bj][m][1] * g1 * ABL_C;
                    *(u32x4*)(mo + (size_t)row * DM + col) = pack8(r0, r1);
                    if (bj == 1) asm volatile("" ::: "memory");
                }
            }
    }
};

struct EpiProj {
    static constexpr bool PERM = true, AFTER_DRAIN = false;
    unsigned char* ws; const float* bgate; float* out; int layer;
    __device__ __forceinline__ void operator()(const Acc& acc, const pg8::Unit& u, int wr, int wc, int fr, int fq) const {
        const int row0 = u.pm * 256 + wr * 64 + fr, lc = wc * 32 + 8 * fq, pn = u.pn;
        const float* rss = (const float*)(ws + WS_RSS); bf16_t* cb = (bf16_t*)(ws + WS_CB); bf16_t* zc = (bf16_t*)(ws + WS_ZC); bf16_t* gates = (bf16_t*)(ws + WS_GATES);
        float invs[2][4]; rows_inv(rss, row0, fq, invs);
        if (pn < 18) {
            const int sel = pn / 6, ct = pn - sel * 6, g = ct >> 1, keep = 128 << (2 * g);
            bf16_t* dst = (bf16_t*)(ws + WS_Q + (size_t)sel * (WS_K - WS_Q)); const float sc = sel == 0 ? QSCALE : 1.f;
            const size_t okp = g == 0 ? O_KVP0 : (g == 1 ? O_KVP1 : O_KVP2), oks = g == 0 ? O_KVS0 : (g == 1 ? O_KVS1 : O_KVS2);
#pragma unroll
            for (int ai = 0; ai < 2; ++ai)
#pragma unroll
                for (int m = 0; m < 4; ++m) {
                    const int row = row0 + ai * 128 + m * 16; const float s = invs[ai][m] * sc;
                    float* o = nullptr;
                    if (sel > 0) {
                        if (row < MP) { const int b = row >> 13, pos = row & 8191; if (pos >= SEQ - keep) o = out + okp + (((size_t)(layer * 2 + b) * keep + (pos - (SEQ - keep))) * 2 + (sel - 1)) * 512; }
                        else if (row < MV) { const int sr = row - MP, bd = sr >> 2, t = sr & 3; o = out + oks + (((size_t)(layer * 32 + bd) * keep + (keep - 4 + t)) * 2 + (sel - 1)) * 512; }
                    }
#pragma unroll
                    for (int bj = 0; bj < 2; ++bj) {
                        const int col = ct * 256 + bj * 128 + lc; const f32x4 v0 = acc[ai][bj][m][0] * s, v1 = acc[ai][bj][m][1] * s;
                        *(u32x4*)(dst + (size_t)row * NQKV + col) = pack8(v0, v1);
                        if (o) { float* p = o + (col & 511); *(f32x4*)p = v0; *(f32x4*)(p + 4) = v1; }
                    }
                }
        } else if (pn < 22) {
            const int ct = pn - 18;
#pragma unroll
            for (int ai = 0; ai < 2; ++ai)
#pragma unroll
                for (int m = 0; m < 4; ++m) {
                    const int row = row0 + ai * 128 + m * 16; const float s = invs[ai][m];
#pragma unroll
                    for (int bj = 0; bj < 2; ++bj) *(u32x4*)(cb + (size_t)row * DM + ct * 256 + bj * 128 + lc) = pack8(acc[ai][bj][m][0] * s, acc[ai][bj][m][1] * s);
                }
        } else if (pn < 30) {
            const int col = (pn - 22) * 128 + lc;
#pragma unroll
            for (int ai = 0; ai < 2; ++ai)
#pragma unroll
                for (int m = 0; m < 4; ++m) {
                    const int row = row0 + ai * 128 + m * 16; const float s = invs[ai][m];
                    const f32x4 z0 = (acc[ai][0][m][0] * s) * (acc[ai][1][m][0] * s), z1 = (acc[ai][0][m][1] * s) * (acc[ai][1][m][1] * s);
                    *(u32x4*)(zc + (size_t)row * DM + col) = pack8(z0, z1);
                    float* o = nullptr;
                    if (row < MP) { const int b = row >> 13, pos = row & 8191; if (pos >= SEQ - 2) o = out + O_CONVP + ((size_t)(layer * 2 + b) * 2 + (pos - (SEQ - 2))) * 1024; }
                    else if (row < MV) { const int sr = row - MP, bd = sr >> 2, t = sr & 3; if (t >= 2) o = out + O_CONVS + ((size_t)(layer * 32 + bd) * 2 + (t - 2)) * 1024; }
                    if (o) { *(f32x4*)(o + col) = z0; *(f32x4*)(o + col + 4) = z1; }
                }
        } else {
            const int ct = pn - 30;
#pragma unroll
            for (int bj = 0; bj < 2; ++bj) {
                const int col = ct * 256 + bj * 128 + lc; const f32x4 b0 = *(const f32x4*)(bgate + col), b1 = *(const f32x4*)(bgate + col + 4);
#pragma unroll
                for (int ai = 0; ai < 2; ++ai)
#pragma unroll
                    for (int m = 0; m < 4; ++m) {
                        const int row = row0 + ai * 128 + m * 16; const float s = invs[ai][m];
                        f32x4 z0 = acc[ai][bj][m][0] * s + b0, z1 = acc[ai][bj][m][1] * s + b1;
#pragma unroll
                        for (int j = 0; j < 4; ++j) { z0[j] = EXP_SIG(z0[j]); z1[j] = EXP_SIG(z1[j]); }
                        *(u32x4*)(gates + (size_t)row * 2048 + col) = pack8(z0, z1);
                    }
            }
        }
    }
};

__device__ __forceinline__ void transpose_item(const float* W, int K, int Nsrc, const float* gain, bf16_t* WT, int dst_row0, int src_col0, int k0, LAS float* scr, int lane) {
#pragma unroll
    for (int i = 0; i < 32; ++i) { const int kk = 2 * i + (lane >> 5); float w = W[(size_t)(k0 + kk) * Nsrc + src_col0 + (lane & 31)]; if (gain) w *= gain[k0 + kk]; scr[kk * 33 + (lane & 31)] = w; }
    LDS_WAIT();
    const int c = lane & 7;
#pragma unroll
    for (int j = 0; j < 4; ++j) { const int n = (lane >> 3) + 8 * j; const LAS float* s = scr + (8 * c) * 33 + n;
        u32x4 o; o.x = cvt_pk_bf16(s[0 * 33], s[1 * 33]); o.y = cvt_pk_bf16(s[2 * 33], s[3 * 33]); o.z = cvt_pk_bf16(s[4 * 33], s[5 * 33]); o.w = cvt_pk_bf16(s[6 * 33], s[7 * 33]);
        *(u32x4*)(WT + (size_t)(dst_row0 + n) * K + k0 + 8 * c) = o; }
    LDS_WAIT();
}

#define DIAG_W 1024
#define DUMP_GATES_RETURN() do { const int t3 = fresh_tid(); const bf16_t* gsrc = (const bf16_t*)(P.ws + WS_GATES); \
    for (size_t i = (size_t)blockIdx.x * 512 + t3; i < (size_t)MV * DM; i += (size_t)gridDim.x * 512) { const size_t row = i >> 10, col = i & 1023; P.out[i] = bf2f(gsrc[row * 2048 + col]) + 2.f * bf2f(gsrc[row * 2048 + 1024 + col]); } \
    return; } while (0)
#define CHECK_GATES(k) do { if (l == 1) { const int t4 = fresh_tid(); const unsigned* gz = (const unsigned*)(P.ws + WS_GATES); bool bad = false; \
    for (size_t i = (size_t)blockIdx.x * 512 + t4; i < (size_t)MV * 1024; i += (size_t)gridDim.x * 512) { const unsigned w = gz[i]; if (fabsf(bf_lo(w)) > 2.f || fabsf(bf_hi(w)) > 2.f) bad = true; } \
    if (bad) atomicOr((unsigned*)(P.ws + WS_CTL) + 8192, 1u << (k)); } } while (0)
struct Params { const float* in[20]; float* out; unsigned char* ws; int ph_lo, ph_hi; };

constexpr int IT_1I = 16 * 176, IT_1O = 44 * 32, IT_IN = 16 * 304, IT_AO = 8 * 32, IT_CO = 16 * 32, IT_O = 16 * 32, IT_LAYER = 2 * IT_1I + 2 * IT_1O + IT_IN + IT_AO + IT_CO + IT_O;

__device__ __forceinline__ void conv_weights(const Params& P, LAS float* scr, int gw, int ngw, int lane) {
    for (int it = gw; it < NLAYER * IT_LAYER; it += ngw) {
        const int l = it / IT_LAYER; int r = it - l * IT_LAYER;
        unsigned char* wl = P.ws + WS_W + (size_t)l * LW_END;
        if (r < 2 * IT_1I) {
            const int f = r / IT_1I; r -= f * IT_1I; const int kb = r / 176, nb = r % 176, R0 = nb * 32;
            const int src = ((R0 & 255) >> 7) * DFF + (R0 >> 8) * 128 + (R0 & 127);
            transpose_item(P.in[f ? 17 : 7] + (size_t)l * DM * 2 * DFF, DM, 2 * DFF, P.in[f ? 16 : 6] + l * DM, (bf16_t*)(wl + (f ? LW_W2I : LW_W1I)), R0, src, kb * 64, scr, lane);
            continue;
        }
        r -= 2 * IT_1I;
        if (r < 2 * IT_1O) {
            const int f = r / IT_1O; r -= f * IT_1O; const int kb = r / 32, nb = r % 32;
            transpose_item(P.in[f ? 18 : 8] + (size_t)l * DFF * DM, DFF, DM, nullptr, (bf16_t*)(wl + (f ? LW_W2O : LW_W1O)), nb * 32, nb * 32, kb * 64, scr, lane);
            continue;
        }
        r -= 2 * IT_1O;
        if (r < IT_IN) {
            const int kb = r / 304, nb = r % 304, R0 = nb * 32; int src = R0;
            if (R0 >= 5632 && R0 < 7680) { const int x = R0 - 5632; src = 5632 + ((x & 255) >> 7) * 1024 + (x >> 8) * 128 + (x & 127); }
            transpose_item(P.in[10] + (size_t)l * DM * NIN, DM, NIN, P.in[9] + l * DM, (bf16_t*)(wl + LW_WIN), R0, src, kb * 64, scr, lane);
            continue;
        }
        r -= IT_IN;
        if (r < IT_AO) { const int kb = r / 32, nb = r % 32; transpose_item(P.in[13] + (size_t)l * 512 * DM, 512, DM, nullptr, (bf16_t*)(wl + LW_WAO), nb * 32, nb * 32, kb * 64, scr, lane); continue; }
        r -= IT_AO;
        if (r < IT_CO) { const int kb = r / 32, nb = r % 32; transpose_item(P.in[14] + (size_t)l * DM * DM, DM, DM, nullptr, (bf16_t*)(wl + LW_WCO), nb * 32, nb * 32, kb * 64, scr, lane); continue; }
        r -= IT_CO;
        { const int kb = r / 32, nb = r % 32; transpose_item(P.in[15] + (size_t)l * DM * DM, DM, DM, nullptr, (bf16_t*)(wl + LW_WO), nb * 32, nb * 32, kb * 64, scr, lane); }
    }
}

__device__ __forceinline__ void init_x(const Params& P, int gw, int ngw, int lane) {
    float* xres = (float*)(P.ws + WS_XRES); bf16_t* xb = (bf16_t*)(P.ws + WS_XB); float* rss = (float*)(P.ws + WS_RSS);
    for (int row = gw; row < MPAD; row += ngw) {
        f32x4 v[4]; float s = 0.f;
        if (row < MV) {
            const f32x4* src = (const f32x4*)(row < MP ? P.in[0] + (size_t)row * DM : P.in[1] + (size_t)(row - MP) * DM) + lane;
#pragma unroll
            for (int j = 0; j < 4; ++j) { v[j] = src[64 * j]; s += (v[j][0] * v[j][0] + v[j][1] * v[j][1]) + (v[j][2] * v[j][2] + v[j][3] * v[j][3]); }
        } else {
#pragma unroll
            for (int j = 0; j < 4; ++j) v[j] = (f32x4){0.f, 0.f, 0.f, 0.f};
        }
        s = wave_sum(s);
        f32x4* xr = (f32x4*)(xres + (size_t)row * DM) + lane; u32x2* xo = (u32x2*)(xb + (size_t)row * DM) + lane;
#pragma unroll
        for (int j = 0; j < 4; ++j) { xr[64 * j] = v[j]; u32x2 w; w.x = cvt_pk_bf16(v[j][0], v[j][1]); w.y = cvt_pk_bf16(v[j][2], v[j][3]); xo[64 * j] = w; }
        if (lane < 16) rss[((size_t)(lane >> 2) * MPAD + row) * 4 + (lane & 3)] = lane == 0 ? s : 0.f;
    }
}

constexpr size_t CP4_0 = (size_t)124 * 256, CP4_1 = (size_t)508 * 256, CP4_2 = (size_t)2044 * 256;
constexpr size_t CPT_0 = CP4_0 * 64, CPT_1 = CPT_0 + CP4_1 * 64, CPT_2 = CPT_1 + CP4_2 * 64;
constexpr size_t CP_ATT_PER_UNIT = 512, CP_ATT_N = (size_t)NLAYER * 3072 * CP_ATT_PER_UNIT, CP_DED_N = (size_t)NLAYER * 3072 * 2048, CP_DED2_N = (size_t)NLAYER * 3072 * 512, CP_DED3_N = (size_t)NLAYER * 3072 * 1024, CP_REST_BEGIN = CP_ATT_N + CP_DED_N + CP_DED2_N + CP_DED3_N;
constexpr int COPY_UNITS = 20;
static_assert(CP_REST_BEGIN < CPT_2 && CP_ATT_N % 256 == 0 && CP_DED_N % 1024 == 0 && CP_DED2_N % 512 == 0, "copy split");
__device__ __forceinline__ void copy_addr(const Params& P, size_t i, const f32x4*& src, f32x4*& dst) {
    const int g = i < CPT_0 ? 0 : (i < CPT_1 ? 1 : 2);
    const size_t j = i - (g == 0 ? 0 : (g == 1 ? CPT_0 : CPT_1)), chunk4 = g == 0 ? CP4_0 : (g == 1 ? CP4_1 : CP4_2), keep4 = chunk4 + 1024;
    const size_t c = j / chunk4, o = j - c * chunk4;
    src = (const f32x4*)P.in[2 + g] + c * keep4 + 1024 + o; dst = (f32x4*)(P.out + (g == 0 ? O_KVS0 : (g == 1 ? O_KVS1 : O_KVS2))) + c * keep4 + o;
}
__device__ __forceinline__ void copy_part(const Params& P, int ubeg, int ucnt) {
    const int bx = fresh_bid();
    if (bx < 4) return;
    constexpr size_t REST = CPT_2 - CP_REST_BEGIN;
    const size_t b = CP_REST_BEGIN + REST * (size_t)ubeg / COPY_UNITS, e = CP_REST_BEGIN + REST * (size_t)(ubeg + ucnt) / COPY_UNITS;
    const size_t stride = (size_t)(gridDim.x - 4) * 512;
    for (size_t i = b + (size_t)((bx - 4) * 512 + fresh_tid()); i < e; i += stride) {
        const f32x4* src; f32x4* dst; copy_addr(P, i, src, dst);
        __builtin_nontemporal_store(__builtin_nontemporal_load(src), dst);
    }
}

constexpr int FFN_UP_GRID = 240;
constexpr int PROJ_GRID = 247;
__device__ __forceinline__ void copy_dedicated(const Params& P, size_t rb, size_t re, int first_block) {
    const int tid = fresh_tid(), lane = tid & 63, wgl = (fresh_bid() - first_block) * 8 + (tid >> 6), nw = ((int)gridDim.x - first_block) * 8;
    for (size_t r0 = rb + (size_t)wgl * 4; r0 < re; r0 += (size_t)nw * 4) {
        f32x4 val[4][4]; f32x4* dstp[4];
#pragma unroll
        for (int u = 0; u < 4; ++u) { const size_t r = r0 + u < re ? r0 + u : re - 1; const f32x4* src; copy_addr(P, r * 256, src, dstp[u]);
#pragma unroll
            for (int qq = 0; qq < 4; ++qq) val[u][qq] = __builtin_nontemporal_load(src + qq * 64 + lane); }
#pragma unroll
        for (int u = 0; u < 4; ++u)
#pragma unroll
            for (int qq = 0; qq < 4; ++qq) __builtin_nontemporal_store(val[u][qq], dstp[u] + qq * 64 + lane);
    }
}

__device__ __forceinline__ void attn_prompt(LAS unsigned char* lds, const Params& P, int layer, const bf16_t* q, const bf16_t* k, const bf16_t* v, bf16_t* og, float* lse) {
    const int tid = fresh_tid();
    const int wid = tid >> 6, lane = tid & 63, fr = lane & 15, fq = lane >> 4, i0 = 16 * wid;
    LAS unsigned char* Ks = lds;
    LAS unsigned char* Vt = lds + 36864;
    const int G = gridDim.x;
    u32x4 kreg[4], va[2], vb[2]; bf16x8 qfN[2]; int nN, gN, hN; size_t qrowN;
#define ATT_LOAD(unit_) do { const int u_ = (unit_); const int b = u_ / 1536; int rem = u_ - b * 1536; gN = rem >> 9; rem &= 511; hN = rem >> 6; const int x = rem & 63; \
        const int dsh = 2 * gN, d = 1 << dsh, r = x & (d - 1); nN = x >> dsh; const int colbase = gN * 512 + hN * 64; const size_t rowbase = (size_t)b * SEQ; \
        _Pragma("unroll") for (int i = 0; i < 4; ++i) { const int c = tid + 512 * i, key = c >> 3, part = c & 7, uu = nN * 128 - 128 + key; \
            kreg[i] = (u32x4){0u, 0u, 0u, 0u}; if (uu >= 0) kreg[i] = *(const u32x4*)(k + (rowbase + (size_t)uu * d + r) * NQKV + colbase + part * 8); } \
        _Pragma("unroll") for (int i = 0; i < 2; ++i) { const int it = tid + 512 * i, pair = it & 127, part = it >> 7, u0 = nN * 128 - 128 + 2 * pair; \
            va[i] = (u32x4){0u, 0u, 0u, 0u}; vb[i] = (u32x4){0u, 0u, 0u, 0u}; \
            if (u0 >= 0) { va[i] = *(const u32x4*)(v + (rowbase + (size_t)u0 * d + r) * NQKV + colbase + part * 8); vb[i] = *(const u32x4*)(v + (rowbase + (size_t)(u0 + 1) * d + r) * NQKV + colbase + part * 8); } } \
        qrowN = rowbase + (size_t)(nN * 128 + i0 + fr) * d + r; \
        _Pragma("unroll") for (int ks = 0; ks < 2; ++ks) qfN[ks] = *(const bf16x8*)(q + qrowN * NQKV + colbase + 32 * ks + 8 * fq); } while (0)
    int unit = blockIdx.x;
    if (unit >= 3072) return;
    ATT_LOAD(unit);
    for (;;) {
        const int n = nN, g = gN, h = hN; const size_t qrow = qrowN; bf16x8 qf[2]; qf[0] = qfN[0]; qf[1] = qfN[1];
        __syncthreads();
#pragma unroll
        for (int i = 0; i < 4; ++i) { const int c = tid + 512 * i, key = c >> 3, part = c & 7; *(LAS u32x4*)(Ks + key * 144 + part * 16) = kreg[i]; }
#pragma unroll
        for (int i = 0; i < 2; ++i) { const int it = tid + 512 * i, pair = it & 127, part = it >> 7;
#pragma unroll
            for (int j = 0; j < 4; ++j) {
                const unsigned wa = va[i][j], wb = vb[i][j];
                *(LAS unsigned*)(Vt + (part * 8 + 2 * j) * 528 + pair * 4) = (wa & 0xffffu) | (wb << 16);
                *(LAS unsigned*)(Vt + (part * 8 + 2 * j + 1) * 528 + pair * 4) = (wa >> 16) | (wb & 0xffff0000u);
            } }
        __syncthreads();
        const int unitN = unit + G; const bool hasN = unitN < 3072;
        if (hasN) ATT_LOAD(unitN);
        f32x4 cpv[1];
#pragma unroll
        for (int i = 0; i < 1; ++i) { const f32x4* src; f32x4* dst; copy_addr(P, ((size_t)layer * 3072 + unit) * CP_ATT_PER_UNIT + i * 512 + tid, src, dst); cpv[i] = __builtin_nontemporal_load(src); }
        f32x4 s[9];
#pragma unroll
        for (int t = 0; t < 9; ++t) { s[t] = (f32x4){0.f, 0.f, 0.f, 0.f};
#pragma unroll
            for (int ks = 0; ks < 2; ++ks) { const bf16x8 kf = *(const LAS bf16x8*)(Ks + (i0 + 16 * t + fr) * 144 + (32 * ks + 8 * fq) * 2);
                s[t] = __builtin_amdgcn_mfma_f32_16x16x32_bf16(kf, qf[ks], s[t], 0, 0, 0); } }
        float mx = -1e30f;
#pragma unroll
        for (int t = 0; t < 9; ++t)
#pragma unroll
            for (int j = 0; j < 4; ++j) { const int rel = 16 * t + 4 * fq + j - fr, kk = i0 + 16 * t + 4 * fq + j;
                const bool valid = rel >= 0 && rel <= 128 && (n > 0 || kk >= 128);
                const float sv = valid ? s[t][j] : -1e30f; s[t][j] = sv; mx = fmaxf(mx, sv); }
        mx = fmaxf(mx, __shfl_xor(mx, 16)); mx = fmaxf(mx, __shfl_xor(mx, 32));
        float l = 0.f;
#pragma unroll
        for (int t = 0; t < 9; ++t)
#pragma unroll
            for (int j = 0; j < 4; ++j) { const float p = fast_exp2(s[t][j] - mx); s[t][j] = p; l += p; }
        l += __shfl_xor(l, 16); l += __shfl_xor(l, 32);
        bf16x8 pf[5];
#pragma unroll
        for (int c = 0; c < 5; ++c) { u32x4 w; w.x = cvt_pk_bf16(s[2 * c][0], s[2 * c][1]); w.y = cvt_pk_bf16(s[2 * c][2], s[2 * c][3]);
            if (c < 4) { w.z = cvt_pk_bf16(s[2 * c + 1][0], s[2 * c + 1][1]); w.w = cvt_pk_bf16(s[2 * c + 1][2], s[2 * c + 1][3]); } else { w.z = 0u; w.w = 0u; }
            pf[c] = __builtin_bit_cast(bf16x8, w); }
        const float invl = fast_rcp(l);
#pragma unroll
        for (int dt = 0; dt < 4; ++dt) { f32x4 o = (f32x4){0.f, 0.f, 0.f, 0.f};
#pragma unroll
            for (int c = 0; c < 5; ++c) { const LAS unsigned char* vp = Vt + (16 * dt + fr) * 528 + (i0 + 32 * c + 4 * fq) * 2;
                const u32x2 lo = *(const LAS u32x2*)vp; u32x2 hi = (u32x2){0u, 0u}; if (c < 4) hi = *(const LAS u32x2*)(vp + 32);
                const u32x4 w = (u32x4){lo.x, lo.y, hi.x, hi.y};
                o = __builtin_amdgcn_mfma_f32_16x16x32_bf16(__builtin_bit_cast(bf16x8, w), pf[c], o, 0, 0, 0); }
            u32x2 w; w.x = cvt_pk_bf16(o[0] * invl, o[1] * invl); w.y = cvt_pk_bf16(o[2] * invl, o[3] * invl);
            *(u32x2*)(og + ((size_t)g * MPAD + qrow) * 512 + h * 64 + 16 * dt + 4 * fq) = w; }
        if (fq == 0) AG_ST(lse + qrow * 24 + g * 8 + h, mx + __builtin_amdgcn_logf(l));
#pragma unroll
        for (int i = 0; i < 1; ++i) { const f32x4* src; f32x4* dst; copy_addr(P, ((size_t)layer * 3072 + unit) * CP_ATT_PER_UNIT + i * 512 + tid, src, dst); __builtin_nontemporal_store(cpv[i], dst); }
        if (!hasN) break;
        unit = unitN;
    }
#undef ATT_LOAD
}

__device__ __forceinline__ void attn_sample(LAS unsigned char* lds, const Params& P, int layer, const bf16_t* q, const bf16_t* k, const bf16_t* v, bf16_t* og, float* lse) {
    const int tid = fresh_tid();
    const int wid = tid >> 6, lane = tid & 63, ksub = lane >> 4, d4 = lane & 15;
    LAS float* sp = (LAS float*)(lds + 73728 + wid * 1024);
    for (int task = blockIdx.x * 8 + wid; task < 3072; task += gridDim.x * 8) {
        const int bd = task / 96; int rem = task - bd * 96; const int t = rem / 24, gh = rem - t * 24, g = gh >> 3, h = gh & 7;
        const int d = 1 << (2 * g), lb = 128 << (2 * g); const int row = MP + bd * 4 + t, colbase = g * 512 + h * 64;
        const float* cache = P.in[2 + g] + (size_t)(layer * 32 + bd) * lb * 1024 + h * 64 + 4 * d4;
        const bf16_t* knew = k + (size_t)(MP + bd * 4) * NQKV + colbase + 4 * d4; const bf16_t* vnew = v + (size_t)(MP + bd * 4) * NQKV + colbase + 4 * d4;
        f32x4 q4; { const u32x2 w = *(const u32x2*)(q + (size_t)row * NQKV + colbase + 4 * d4); q4 = (f32x4){bf_lo(w.x), bf_hi(w.x), bf_lo(w.y), bf_hi(w.y)}; }
        LDS_WAIT();
#pragma unroll 1
        for (int bt = 0; bt < 3; ++bt) {
            f32x4 kv[11];
#pragma unroll
            for (int i = 0; i < 11; ++i) { const int j = 4 * (bt * 11 + i) + ksub; kv[i] = (f32x4){0.f, 0.f, 0.f, 0.f};
                if (j <= 128) { const int idx = lb + t - d * j;
                    if (idx >= lb) { const u32x2 w = *(const u32x2*)(knew + (size_t)(idx - lb) * NQKV); kv[i] = (f32x4){bf_lo(w.x), bf_hi(w.x), bf_lo(w.y), bf_hi(w.y)}; }
                    else kv[i] = *(const f32x4*)(cache + (size_t)idx * 1024); } }
#pragma unroll
            for (int i = 0; i < 11; ++i) { const int j = 4 * (bt * 11 + i) + ksub;
                float pd = (kv[i][0] * q4[0] + kv[i][1] * q4[1]) + (kv[i][2] * q4[2] + kv[i][3] * q4[3]);
                pd += __shfl_xor(pd, 1); pd += __shfl_xor(pd, 2); pd += __shfl_xor(pd, 4); pd += __shfl_xor(pd, 8);
                if (d4 == 0 && j <= 128) sp[j] = pd; }
        }
        LDS_WAIT();
        const float s0 = sp[lane], s1 = sp[lane + 64], s2 = lane == 0 ? sp[128] : -1e30f;
        const float mx = wave_max(fmaxf(s0, fmaxf(s1, s2)));
        const float p0 = fast_exp2(s0 - mx), p1 = fast_exp2(s1 - mx), p2 = lane == 0 ? fast_exp2(s2 - mx) : 0.f;
        const float l = wave_sum(p0 + p1 + p2);
        LDS_WAIT();
        sp[lane] = p0; sp[lane + 64] = p1; if (lane == 0) sp[128] = p2;
        LDS_WAIT();
        f32x4 acc = (f32x4){0.f, 0.f, 0.f, 0.f};
#pragma unroll 1
        for (int bt = 0; bt < 3; ++bt) {
            f32x4 vv[11];
#pragma unroll
            for (int i = 0; i < 11; ++i) { const int j = 4 * (bt * 11 + i) + ksub; vv[i] = (f32x4){0.f, 0.f, 0.f, 0.f};
                if (j <= 128) { const int idx = lb + t - d * j;
                    if (idx >= lb) { const u32x2 w = *(const u32x2*)(vnew + (size_t)(idx - lb) * NQKV); vv[i] = (f32x4){bf_lo(w.x), bf_hi(w.x), bf_lo(w.y), bf_hi(w.y)}; }
                    else vv[i] = *(const f32x4*)(cache + (size_t)idx * 1024 + 512); } }
#pragma unroll
            for (int i = 0; i < 11; ++i) { const int j = 4 * (bt * 11 + i) + ksub; const float pj = j <= 128 ? sp[j] : 0.f; acc += vv[i] * pj; }
        }
#pragma unroll
        for (int c = 0; c < 4; ++c) { float a = acc[c]; a += __shfl_xor(a, 16); a += __shfl_xor(a, 32); acc[c] = a; }
        const float invl = fast_rcp(l);
        if (ksub == 0) { u32x2 w; w.x = cvt_pk_bf16(acc[0] * invl, acc[1] * invl); w.y = cvt_pk_bf16(acc[2] * invl, acc[3] * invl);
            *(u32x2*)(og + ((size_t)g * MPAD + row) * 512 + h * 64 + 4 * d4) = w; }
        if (lane == 0) AG_ST(lse + (size_t)row * 24 + g * 8 + h, mx + __builtin_amdgcn_logf(l));
    }
}

__device__ __forceinline__ void merge_conv(const Params& P, int layer) {
    const int tid = fresh_tid(), lane = tid & 63, gw = blockIdx.x * 8 + (tid >> 6), ngw = gridDim.x * 8;
    const bf16_t* og = (const bf16_t*)(P.ws + WS_OG); const float* lse = (const float*)(P.ws + WS_LSE);
    bf16_t* a = (bf16_t*)(P.ws + WS_A); bf16_t* c = (bf16_t*)(P.ws + WS_C);
    const bf16_t* cb = (const bf16_t*)(P.ws + WS_CB); const bf16_t* zc = (const bf16_t*)(P.ws + WS_ZC);
    const float* cw = P.in[12] + (size_t)layer * 3 * 1024; const float* st = P.in[5];
    for (int row = gw; row < MV; row += ngw) {
        {
            const int head = lane >> 3; const float* lp = lse + (size_t)row * 24 + head;
            const float l0 = AG_LD(lp), l1 = AG_LD(lp + 8), l2 = AG_LD(lp + 16), mx = fmaxf(l0, fmaxf(l1, l2));
            float w0 = fast_exp2(l0 - mx), w1 = fast_exp2(l1 - mx), w2 = fast_exp2(l2 - mx); const float inv = fast_rcp(w0 + w1 + w2); w0 *= inv; w1 *= inv; w2 *= inv;
            f32x4 x0, x1, y0, y1, z0, z1;
            unpack8(*(const u32x4*)(og + ((size_t)0 * MPAD + row) * 512 + 8 * lane), x0, x1);
            unpack8(*(const u32x4*)(og + ((size_t)1 * MPAD + row) * 512 + 8 * lane), y0, y1);
            unpack8(*(const u32x4*)(og + ((size_t)2 * MPAD + row) * 512 + 8 * lane), z0, z1);
            *(u32x4*)(a + (size_t)row * 512 + 8 * lane) = pack8(x0 * w0 + y0 * w1 + z0 * w2, x1 * w0 + y1 * w1 + z1 * w2);
        }
#pragma unroll
        for (int hf = 0; hf < 2; ++hf) {
            const int ch = 16 * lane + 8 * hf;
            f32x4 b0, b1, t0a, t0b, t1a, t1b, t2a, t2b;
            unpack8(*(const u32x4*)(cb + (size_t)row * DM + ch), b0, b1);
            unpack8(*(const u32x4*)(zc + (size_t)row * DM + ch), t0a, t0b);
            bool has1, has2; const float* s1 = nullptr; const float* s2 = nullptr;
            if (row < MP) { const int pos = row & 8191; has1 = pos >= 1; has2 = pos >= 2; }
            else { const int sr = row - MP, bd = sr >> 2, t = sr & 3; has1 = t >= 1; has2 = t >= 2;
                s1 = st + ((size_t)(layer * 32 + bd) * 2 + 1) * 1024 + ch; s2 = st + ((size_t)(layer * 32 + bd) * 2 + t) * 1024 + ch; }
            if (has1) unpack8(*(const u32x4*)(zc + (size_t)(row - 1) * DM + ch), t1a, t1b);
            else if (s1) { t1a = *(const f32x4*)s1; t1b = *(const f32x4*)(s1 + 4); } else { t1a = (f32x4){0.f, 0.f, 0.f, 0.f}; t1b = t1a; }
            if (has2) unpack8(*(const u32x4*)(zc + (size_t)(row - 2) * DM + ch), t2a, t2b);
            else if (s2) { t2a = *(const f32x4*)s2; t2b = *(const f32x4*)(s2 + 4); } else { t2a = (f32x4){0.f, 0.f, 0.f, 0.f}; t2b = t2a; }
            const f32x4 w0a = *(const f32x4*)(cw + ch), w0b = *(const f32x4*)(cw + ch + 4), w1a = *(const f32x4*)(cw + 1024 + ch), w1b = *(const f32x4*)(cw + 1024 + ch + 4),
                        w2a = *(const f32x4*)(cw + 2048 + ch), w2b = *(const f32x4*)(cw + 2048 + ch + 4);
            *(u32x4*)(c + (size_t)row * DM + ch) = pack8(b0 * (w0a * t2a + w1a * t1a + w2a * t0a), b1 * (w0b * t2b + w1b * t1b + w2b * t0b));
        }
    }
}

__device__ __forceinline__ void final_norm(const Params& P) {
    const int tid = fresh_tid(), lane = tid & 63, gw = blockIdx.x * 8 + (tid >> 6), ngw = gridDim.x * 8;
    const float* xres = (const float*)(P.ws + WS_XRES); const f32x4* gn = (const f32x4*)P.in[19] + lane;
    for (int row = gw; row < MV; row += ngw) {
        const f32x4* xr = (const f32x4*)(xres + (size_t)row * DM) + lane; f32x4 v[4]; float s = 0.f;
#pragma unroll
        for (int j = 0; j < 4; ++j) { v[j] = xr[64 * j]; s += (v[j][0] * v[j][0] + v[j][1] * v[j][1]) + (v[j][2] * v[j][2] + v[j][3] * v[j][3]); }
        const float inv = __builtin_amdgcn_rsqf(wave_sum(s) * (1.0f / 1024.0f) + RMS_EPS);
        f32x4* o = (f32x4*)(P.out + (row < MP ? O_YP + (size_t)row * DM : O_YS + (size_t)(row - MP) * DM)) + lane;
#pragma unroll
        for (int j = 0; j < 4; ++j) o[64 * j] = v[j] * inv * gn[64 * j];
    }
}

#define XB_TMO      128
#define XB_XCNT(j)  (256  + 64 * (j))
#define XB_XSUB(j)  (1280 + 64 * (j))
#define XB_XGEN(j)  (2304 + 64 * (j))
#define XB_TOP      3328
#define XB_TOPGEN   3392
#define XCD_BAR_WORDS 3456
#define XB_SPIN_CAP (1u << 18)

__device__ __forceinline__ unsigned xb_ld(unsigned* p)              { return __hip_atomic_load(p, __ATOMIC_RELAXED, __HIP_MEMORY_SCOPE_AGENT); }
__device__ __forceinline__ unsigned xb_add(unsigned* p, unsigned v) { return __hip_atomic_fetch_add(p, v, __ATOMIC_RELAXED, __HIP_MEMORY_SCOPE_AGENT); }
__device__ __forceinline__ unsigned xb_xcc_id() { return (unsigned)__builtin_amdgcn_s_getreg((3 << 11) | 20) & 0xFu; }
#define XB_SPIN(cond, bar) do { unsigned _sp = 0; while (cond) { __builtin_amdgcn_s_sleep(1); \
    if ((++_sp & 255u) == 0u) { if (xb_ld(&(bar)[XB_TMO])) break; if (_sp > XB_SPIN_CAP) { atomicAdd(&(bar)[XB_TMO], 1u); break; } } } } while (0)

struct XcdBarrier {
    unsigned* bar; unsigned x;
    volatile LAS unsigned* st;
};

__device__ __forceinline__ XcdBarrier xcd_barrier_post(unsigned* bar, volatile LAS unsigned* st) {
    XcdBarrier b; b.bar = bar; b.x = xb_xcc_id(); b.st = st;
    if (threadIdx.x == 0) (void)xb_add(&bar[XB_XCNT(b.x)], 1u);
    return b;
}
__device__ __forceinline__ void xcd_barrier_complete(unsigned* bar, unsigned x, unsigned& nloc, unsigned& nx) {
    const unsigned G = gridDim.x * gridDim.y * gridDim.z;
    unsigned sum, cnt, mine, sp = 0u;
    for (;;) {
        sum = 0u; cnt = 0u; mine = 0u;
#pragma unroll
        for (unsigned j = 0; j < 16; ++j) { const unsigned c = xb_ld(&bar[XB_XCNT(j)]); sum += c; cnt += (c > 0u) ? 1u : 0u; mine = (j == x) ? c : mine; }
        if (sum == G) break;
        __builtin_amdgcn_s_sleep(1);
        if ((++sp & 255u) == 0u) { if (xb_ld(&bar[XB_TMO])) break; if (sp > XB_SPIN_CAP) { atomicAdd(&bar[XB_TMO], 1u); break; } }
    }
    nloc = mine > 0u ? mine : 1u; nx = cnt > 0u ? cnt : 1u;
}

__device__ __forceinline__ void xcd_barrier(const XcdBarrier& b) {
    asm volatile("s_waitcnt vmcnt(0)" ::: "memory");
    __syncthreads();
    if (threadIdx.x == 0) {
        unsigned* bar = b.bar;
        __builtin_amdgcn_s_waitcnt(0);
        unsigned nloc = b.st[0], nx = b.st[1];
        if (nloc == 0u) { xcd_barrier_complete(bar, b.x, nloc, nx); b.st[0] = nloc; b.st[1] = nx; }
        const unsigned old = xb_add(&bar[XB_XSUB(b.x)], 1u);
        const unsigned gen = old / nloc;
        if (old + 1u == (gen + 1u) * nloc) {
            __builtin_amdgcn_fence(__ATOMIC_RELEASE, "agent");
            asm volatile("s_waitcnt vmcnt(0)" ::: "memory");
            const unsigned og = xb_add(&bar[XB_TOP], 1u);
            const unsigned tg = og / nx;
            if (og + 1u == (tg + 1u) * nx) xb_add(&bar[XB_TOPGEN], 1u);
            else XB_SPIN(xb_ld(&bar[XB_TOPGEN]) == tg, bar);
            __builtin_amdgcn_fence(__ATOMIC_ACQUIRE, "agent");
            xb_add(&bar[XB_XGEN(b.x)], 1u);
            asm volatile("s_waitcnt vmcnt(0)" ::: "memory");
        } else {
            XB_SPIN(xb_ld(&bar[XB_XGEN(b.x)]) == gen, bar);
            __builtin_amdgcn_fence(__ATOMIC_ACQUIRE, "agent");
            asm volatile("s_waitcnt vmcnt(0)" ::: "memory");
        }
    }
    __syncthreads();
}

template <int MODE  >
__device__ __forceinline__ void sample_strip(LAS unsigned char* lds, const bf16_t* A, const bf16_t* Bt, int K, unsigned char* ws, float scale) {
    const int bx = fresh_bid();
    if (bx < 4 || bx >= 132) return;
    const int tid = fresh_tid(), lane = tid & 63, wave = tid >> 6, fr = lane & 15, fq = lane >> 4, sid = bx - 4;
    const int r0 = MP + 16 * (sid & 7), c0 = 64 * (sid >> 3), kw = K >> 3, kb = wave * kw;
    const bf16_t* ap = A + (size_t)(r0 + fr) * K + kb + 8 * fq; const bf16_t* bp = Bt + (size_t)(c0 + fr) * K + kb + 8 * fq;
    f32x4 acc[4];
#pragma unroll
    for (int t = 0; t < 4; ++t) acc[t] = (f32x4){0.f, 0.f, 0.f, 0.f};
#pragma unroll 11
    for (int k = 0; k < kw; k += 32) {
        const bf16x8 af = *(const bf16x8*)(ap + k);
#pragma unroll
        for (int t = 0; t < 4; ++t) { const bf16x8 bf = *(const bf16x8*)(bp + (size_t)(16 * t) * K + k); acc[t] = __builtin_amdgcn_mfma_f32_16x16x32_bf16(bf, af, acc[t], 0, 0, 0); }
    }
    LAS f32x4* red = (LAS f32x4*)lds;
#pragma unroll
    for (int t = 0; t < 4; ++t) red[(wave * 4 + t) * 64 + lane] = acc[t];
    __syncthreads();
    if (wave == 0) {
#pragma unroll
        for (int w = 1; w < 8; ++w)
#pragma unroll
            for (int t = 0; t < 4; ++t) acc[t] += red[(w * 4 + t) * 64 + lane];
    }
    __syncthreads();
    if (wave != 0) return;
    const int row = r0 + fr;
    if (MODE == 0) {
        float* xres = (float*)(ws + WS_XRES); bf16_t* xb = (bf16_t*)(ws + WS_XB); float* rss = (float*)(ws + WS_RSS); float ss = 0.f;
#pragma unroll
        for (int t = 0; t < 4; ++t) { const int col = c0 + 16 * t + 4 * fq; float* p = xres + (size_t)row * DM + col; f32x4 r = *(const f32x4*)p; r += acc[t] * scale; *(f32x4*)p = r;
            u32x2 w; w.x = cvt_pk_bf16(r[0], r[1]); w.y = cvt_pk_bf16(r[2], r[3]); *(u32x2*)(xb + (size_t)row * DM + col) = w;
            ss += (r[0] * r[0] + r[1] * r[1]) + (r[2] * r[2] + r[3] * r[3]); }
        ss += __shfl_xor(ss, 16); ss += __shfl_xor(ss, 32);
        if (fq == 0) AG_ST(rss + ((size_t)(c0 >> 8) * MPAD + row) * 4 + ((c0 >> 6) & 3), ss);
    } else {
        const bf16_t* gates = (const bf16_t*)(ws + WS_GATES); float* mtmp = (float*)(ws + WS_MTMP); bf16_t* mo = (bf16_t*)(ws + WS_M);
#pragma unroll
        for (int t = 0; t < 4; ++t) { const int col = c0 + 16 * t + 4 * fq; const u32x2 gw = *(const u32x2*)(gates + (size_t)row * 2048 + (MODE == 2 ? 1024 : 0) + col);
            const f32x4 g = (f32x4){bf_lo(gw.x), bf_hi(gw.x), bf_lo(gw.y), bf_hi(gw.y)}; float* p = mtmp + (size_t)row * DM + col;
            if (MODE == 1) *(f32x4*)p = acc[t] * g;
            else { const f32x4 r = *(const f32x4*)p + acc[t] * g; u32x2 w; w.x = cvt_pk_bf16(r[0], r[1]); w.y = cvt_pk_bf16(r[2], r[3]); *(u32x2*)(mo + (size_t)row * DM + col) = w; } }
    }
}

#ifndef N_LAUNCHES
#define N_LAUNCHES 1
#endif
constexpr int N_PHASES = 20;
__global__ void __launch_bounds__(512, 2) fwd_megakernel(Params P) {
    extern __shared__ __attribute__((aligned(16))) unsigned char lds_raw[];
    LAS unsigned char* lds = (LAS unsigned char*)lds_raw;
    cg::grid_group grid = cg::this_grid();
    volatile LAS unsigned* xst = (volatile LAS unsigned*)(lds + 133120);
    if (threadIdx.x < 2) xst[threadIdx.x] = 0u;
    __syncthreads();
    XcdBarrier xbar; xbar.bar = (unsigned*)(P.ws + WS_CTL); xbar.x = 0; xbar.st = xst;
    if (P.ph_hi - P.ph_lo > 1) xbar = xcd_barrier_post((unsigned*)(P.ws + WS_CTL), xst);
    if (P.ws == nullptr) grid.sync();
    const int G = gridDim.x;
    const int lo = P.ph_lo, hi = P.ph_hi;
    int ph = 0;
#define WSF() ({ size_t z_ = 0; asm volatile("" : "+s"(z_)); P.ws + z_; })
#define RUN (ph >= lo && ph < hi)
#define SEAM() do { if (ph >= lo && ph + 1 < hi) xcd_barrier(xbar); ++ph; } while (0)

    if (RUN) {
        const int tid = fresh_tid(), lane = tid & 63, wave = tid >> 6, gw = blockIdx.x * 8 + wave, ngw = G * 8;
        conv_weights(P, (LAS float*)(lds + wave * 16384), gw, ngw, lane);
        init_x(P, gw, ngw, lane);
    }
    SEAM();
#pragma unroll 1
    for (int l = 0; l < NLAYER; ++l) {
#pragma unroll 1
        for (int f = 0; f < 2; ++f) {
            if (RUN) {
                unsigned char* ws = WSF(); unsigned char* wl = ws + WS_W + (size_t)l * LW_END;
                if (G > FFN_UP_GRID && (int)blockIdx.x >= FFN_UP_GRID) { constexpr size_t R0 = CP_ATT_N / 256, RN = CP_DED_N / 256; copy_dedicated(P, R0 + RN * (size_t)(2 * l + f) / 4, R0 + RN * (size_t)(2 * l + f + 1) / 4, FFN_UP_GRID); }
                else {
                pg8::Gemm g{(const bf16_t*)(ws + WS_XB), (const bf16_t*)(wl + (f ? LW_W2I : LW_W1I)), MPAD, 2 * DFF, DM}; pg8::StaticOrder S; S.init(MPAD, 2 * DFF, G > FFN_UP_GRID ? FFN_UP_GRID : G, (int)blockIdx.x);
                EpiSwiGLU E{(bf16_t*)(ws + WS_ACT), (const float*)(ws + WS_RSS)};
                pg8::gemm_phase<EpiSwiGLU, pg8::StaticOrder, true, true>(lds, g, S, E);
                }
            }
            SEAM();
            if (RUN) {
                unsigned char* ws = WSF(); unsigned char* wl = ws + WS_W + (size_t)l * LW_END;
                pg8::Gemm g{(const bf16_t*)(ws + WS_ACT), (const bf16_t*)(wl + (f ? LW_W2O : LW_W1O)), MP, DM, DFF}; pg8::StaticOrder S; S.init(MP, DM, G, (int)blockIdx.x);
                EpiResid E{(float*)(ws + WS_XRES), (bf16_t*)(ws + WS_XB), (float*)(ws + WS_RSS), 0.5f};
                pg8::gemm_phase<EpiResid, pg8::StaticOrder, true, true>(lds, g, S, E);
                sample_strip<0>(lds, (const bf16_t*)(ws + WS_ACT), (const bf16_t*)(wl + (f ? LW_W2O : LW_W1O)), DFF, ws, 0.5f);
                if (G > 132 && (int)blockIdx.x >= 132) { constexpr size_t R0 = (CP_ATT_N + CP_DED_N + CP_DED2_N) / 256, RN = CP_DED3_N / 256;
                    copy_dedicated(P, R0 + RN * (size_t)(2 * l + f) / 4, R0 + RN * (size_t)(2 * l + f + 1) / 4, 132); }
            }
            SEAM();
            if (f == 0) {
                if (RUN) {
                    unsigned char* ws = WSF(); unsigned char* wl = ws + WS_W + (size_t)l * LW_END;
                    if (G > PROJ_GRID && (int)blockIdx.x >= PROJ_GRID) { constexpr size_t R0 = (CP_ATT_N + CP_DED_N) / 256, RN = CP_DED2_N / 256; copy_dedicated(P, R0 + RN * (size_t)l / 2, R0 + RN * (size_t)(l + 1) / 2, PROJ_GRID); }
                    else {
                    pg8::Gemm g{(const bf16_t*)(ws + WS_XB), (const bf16_t*)(wl + LW_WIN), MPAD, NIN, DM}; pg8::StaticOrder S; S.init(MPAD, NIN, G > PROJ_GRID ? PROJ_GRID : G, (int)blockIdx.x);
                    EpiProj E{ws, P.in[11] + (size_t)l * 2048, P.out, l};
                    pg8::gemm_phase<EpiProj, pg8::StaticOrder, true, true>(lds, g, S, E);
                    }
                }
                SEAM();
                if (RUN) {
                    unsigned char* ws = WSF();
                    attn_prompt(lds, P, l, (const bf16_t*)(ws + WS_Q), (const bf16_t*)(ws + WS_K), (const bf16_t*)(ws + WS_V), (bf16_t*)(ws + WS_OG), (float*)(ws + WS_LSE));
                    attn_sample(lds, P, l, (const bf16_t*)(ws + WS_Q), (const bf16_t*)(ws + WS_K), (const bf16_t*)(ws + WS_V), (bf16_t*)(ws + WS_OG), (float*)(ws + WS_LSE));
                }
                SEAM();
                if (RUN) merge_conv(P, l);
                SEAM();
                if (RUN) {
                    {
                        unsigned char* ws = WSF(); unsigned char* wl = ws + WS_W + (size_t)l * LW_END;
                        pg8::StaticOrder S; S.init(MPAD, DM, G, (int)blockIdx.x);
                        pg8::Gemm g1{(const bf16_t*)(ws + WS_A), (const bf16_t*)(wl + LW_WAO), MPAD, DM, 512}; EpiMixA E1{(const bf16_t*)(ws + WS_GATES), (float*)(ws + WS_MTMP)};
                        pg8::gemm_phase<EpiMixA, pg8::StaticOrder, true, true>(lds, g1, S, E1);
                    }
                    {
                        unsigned char* ws = WSF(); unsigned char* wl = ws + WS_W + (size_t)l * LW_END;
                        pg8::StaticOrder S; S.init(MPAD, DM, G, (int)blockIdx.x);
                        pg8::Gemm g2{(const bf16_t*)(ws + WS_C), (const bf16_t*)(wl + LW_WCO), MPAD, DM, DM}; EpiMixB E2{(const bf16_t*)(ws + WS_GATES), (const float*)(ws + WS_MTMP), (bf16_t*)(ws + WS_M)};
                        pg8::gemm_phase<EpiMixB, pg8::StaticOrder, true, true>(lds, g2, S, E2);
                        copy_part(P, 10 * l, 6);
                    }
                }
                SEAM();
                if (RUN) {
                    unsigned char* ws = WSF(); unsigned char* wl = ws + WS_W + (size_t)l * LW_END;
                    pg8::Gemm g{(const bf16_t*)(ws + WS_M), (const bf16_t*)(wl + LW_WO), MPAD, DM, DM}; pg8::StaticOrder S; S.init(MPAD, DM, G, (int)blockIdx.x);
                    EpiResid E{(float*)(ws + WS_XRES), (bf16_t*)(ws + WS_XB), (float*)(ws + WS_RSS), 1.0f};
                    pg8::gemm_phase<EpiResid, pg8::StaticOrder, true, true>(lds, g, S, E);
                    copy_part(P, 10 * l + 6, 4);
                }
                SEAM();
            }
        }
    }
    if (RUN) {
#ifdef DUMPG
      const int tid2 = fresh_tid(); const bf16_t* gsrc = (const bf16_t*)(P.ws + WS_GATES);
      for (size_t i = (size_t)blockIdx.x * 512 + tid2; i < (size_t)MV * DM; i += (size_t)gridDim.x * 512) { const size_t row = i >> 10, col = i & 1023; P.out[i] = bf2f(gsrc[row * 2048 + col]) + 2.f * bf2f(gsrc[row * 2048 + 1024 + col]); }
#else
      final_norm(P);
#endif
    }
}

extern "C" void kernel_launch(void* const* d_in, const int* in_sizes, int n_in, void* d_out, int out_size, void* d_ws, size_t ws_size, hipStream_t stream) {
    static int grid = 0;
    if (grid == 0) {
        if (n_in != 20 || ws_size < WS_END) { fprintf(stderr, "kernel_launch: unexpected n_in %d / ws %zu (need %zu)\n", n_in, ws_size, (size_t)WS_END); grid = -1; return; }
        int dev = 0, cus = 0;
        (void)hipGetDevice(&dev); (void)hipDeviceGetAttribute(&cus, hipDeviceAttributeMultiprocessorCount, dev);
        (void)hipFuncSetAttribute((const void*)fwd_megakernel, hipFuncAttributeMaxDynamicSharedMemorySize, LDS_BYTES);
        grid = cus;
        (void)hipGetLastError();
    }
    if (grid < 0) return;
    (void)hipMemsetAsync((char*)d_ws + WS_CTL, 0, CTL_BYTES, stream);
    Params p{};
    for (int i = 0; i < 20; ++i) p.in[i] = (const float*)d_in[i];
    p.out = (float*)d_out; p.ws = (unsigned char*)d_ws;
    for (int li = 0; li < N_LAUNCHES; ++li) {
        p.ph_lo = (N_LAUNCHES == 1) ? 0 : li; p.ph_hi = (N_LAUNCHES == 1) ? N_PHASES : li + 1;
        void* args[] = {&p};
        hipError_t e = hipLaunchCooperativeKernel((const void*)fwd_megakernel, dim3(grid), dim3(512), args, LDS_BYTES, stream);
        if (e != hipSuccess) { fprintf(stderr, "cooperative launch failed: %s (grid %d)\n", hipGetErrorString(e), grid); break; }
    }
}
```
